# Optimizing an MI355X kernel written in HIP

```python
import math
import jax, jax.numpy as jnp
from jax import lax
import numpy as np

D_MODEL = 1024
BATCH = 2
SEQ = 8192
DEPTH = 2
DEC_BATCH = 4
DEC_SEQ = 8192
PAST_LEN = 128

CHUNK = 128
A_WIDTH = 1024
A_GROUPS = 8
A_GROUP_DIM = A_WIDTH // A_GROUPS
B_WIDTH = 1024
B_GROUP_DIM = 16
B_GROUPS = B_WIDTH // B_GROUP_DIM
B_STATE = 64
N_BRANCH = 2
D_FF = 4 * D_MODEL
IN_WIDTH = 2 * A_WIDTH + B_WIDTH + N_BRANCH * D_MODEL
EPS = 1e-6
DT_MIN = 1e-3
DT_MAX = 1e-1

kernel_name = "hybrid_gmlp_s5_bidir_encoder"


def rmsnorm(x, g):
    xf = x.astype(jnp.float32)
    y = xf * lax.rsqrt(jnp.mean(xf * xf, axis=-1, keepdims=True) + EPS) * g.astype(jnp.float32)
    return y.astype(x.dtype)


def spatial_gating(u, v, norm_v, w_s, b_s):
    bsz, s, _ = v.shape
    v = rmsnorm(v, norm_v).reshape(bsz, s // CHUNK, CHUNK, A_GROUPS, A_GROUP_DIM)
    mixed = jnp.einsum('gpq,bnqgc->bnpgc', w_s, v) + b_s.T[None, None, :, :, None]
    return u * mixed.reshape(bsz, s, A_WIDTH)


def s5_direction(u, lam_re, lam_im, log_dt, b_re, b_im, c_re, c_im):
    lam = lax.complex(lam_re.astype(jnp.float32), lam_im.astype(jnp.float32))
    dt = jnp.exp(log_dt.astype(jnp.float32))[:, None]
    a_bar = jnp.exp(lam * dt)
    b_mat = lax.complex(b_re.astype(jnp.float32), b_im.astype(jnp.float32))
    b_bar = ((a_bar - 1.0) / lam)[:, :, None] * b_mat
    bu = jnp.einsum('gph,bsgh->bsgp', b_bar, u.astype(b_bar.dtype))
    a_seq = jnp.broadcast_to(a_bar, bu.shape)

    def combine(left, right):
        a_l, s_l = left
        a_r, s_r = right
        return a_l * a_r, a_r * s_l + s_r

    _, states = lax.associative_scan(combine, (a_seq, bu), axis=1)
    c_mat = lax.complex(c_re.astype(jnp.float32), c_im.astype(jnp.float32))
    return jnp.einsum('ghp,bsgp->bsgh', c_mat, states).real


def s5_branch(u, l, p):
    bsz, s, _ = u.shape
    ug = u.astype(jnp.float32).reshape(bsz, s, B_GROUPS, B_GROUP_DIM)
    y_f = s5_direction(ug, p['lam_re'][l, 0], p['lam_im'][l, 0], p['log_dt'][l, 0],
                       p['b_re'][l, 0], p['b_im'][l, 0], p['c_re'][l, 0], p['c_im'][l, 0])
    y_b = jnp.flip(s5_direction(jnp.flip(ug, axis=1), p['lam_re'][l, 1], p['lam_im'][l, 1],
                                p['log_dt'][l, 1], p['b_re'][l, 1], p['b_im'][l, 1],
                                p['c_re'][l, 1], p['c_im'][l, 1]), axis=1)
    y = (y_f + y_b).reshape(bsz, s, B_WIDTH) + p['d_skip'][l].astype(jnp.float32) * ug.reshape(bsz, s, B_WIDTH)
    z = jax.nn.gelu(y).astype(u.dtype)
    glu = z @ p['w_glu'][l]
    g1, g2 = jnp.split(glu, 2, axis=-1)
    return g1 * jax.nn.sigmoid(g2)


def layer(x, l, p):
    h = rmsnorm(x, p['norm_pre_mix'][l])
    proj = h @ p['w_in'][l]
    u_a, v_a, u_b, gate_logits = jnp.split(
        proj, [A_WIDTH, 2 * A_WIDTH, 2 * A_WIDTH + B_WIDTH], axis=-1)
    a = spatial_gating(jax.nn.gelu(u_a), jax.nn.gelu(v_a), p['norm_v'][l],
                       p['w_s'][l], p['b_s'][l]) @ p['w_out_a'][l]
    b = s5_branch(u_b, l, p)
    g_a, g_b = jnp.split(jax.nn.sigmoid(gate_logits), 2, axis=-1)
    mix = (g_a * a + g_b * b) @ p['w_o'][l]
    x = x + rmsnorm(mix, p['norm_post_mix'][l])
    h = rmsnorm(x, p['norm_pre_ff'][l])
    f = jnp.square(jax.nn.relu(h @ p['w_ff1'][l])) @ p['w_ff2'][l]
    return x + rmsnorm(f, p['norm_post_ff'][l])


def trunk(x, p):
    for l in range(DEPTH):
        x = layer(x, l, p)
    return x


def setup_inputs(seed: int = 0) -> dict:
    key = jax.random.key(seed)
    k = jax.random.split(key, 24)
    f32 = jnp.float32

    def nrm(kk, shape, scale):
        return jax.random.normal(kk, shape, f32) * scale

    n_idx = jnp.arange(B_STATE, dtype=f32)
    lam_re = -0.5 + nrm(k[10], (DEPTH, 2, B_GROUPS, B_STATE), 0.01)
    lam_im = math.pi * n_idx + nrm(k[11], (DEPTH, 2, B_GROUPS, B_STATE), 0.01)
    log_dt = jax.random.uniform(k[12], (DEPTH, 2, B_GROUPS), f32,
                                math.log(DT_MIN), math.log(DT_MAX))
    return {
        'x_prompt': jax.random.normal(k[0], (BATCH, SEQ, D_MODEL), f32),
        'x_sample': jax.random.normal(k[1], (DEC_BATCH, DEC_SEQ, D_MODEL), f32),
        'norm_pre_mix': 1.0 + nrm(k[2], (DEPTH, D_MODEL), 0.02),
        'w_in': nrm(k[3], (DEPTH, D_MODEL, IN_WIDTH), D_MODEL ** -0.5),
        'norm_v': 1.0 + nrm(k[4], (DEPTH, A_WIDTH), 0.02),
        'w_s': nrm(k[5], (DEPTH, A_GROUPS, CHUNK, CHUNK), CHUNK ** -0.5),
        'b_s': 1.0 + nrm(k[6], (DEPTH, A_GROUPS, CHUNK), 0.02),
        'w_out_a': nrm(k[7], (DEPTH, A_WIDTH, D_MODEL), A_WIDTH ** -0.5),
        'lam_re': lam_re,
        'lam_im': lam_im,
        'log_dt': log_dt,
        'b_re': nrm(k[13], (DEPTH, 2, B_GROUPS, B_STATE, B_GROUP_DIM), (2 * B_GROUP_DIM) ** -0.5),
        'b_im': nrm(k[14], (DEPTH, 2, B_GROUPS, B_STATE, B_GROUP_DIM), (2 * B_GROUP_DIM) ** -0.5),
        'c_re': nrm(k[15], (DEPTH, 2, B_GROUPS, B_GROUP_DIM, B_STATE), (2 * B_STATE) ** -0.5),
        'c_im': nrm(k[16], (DEPTH, 2, B_GROUPS, B_GROUP_DIM, B_STATE), (2 * B_STATE) ** -0.5),
        'd_skip': nrm(k[17], (DEPTH, B_WIDTH), 1.0),
        'w_glu': nrm(k[18], (DEPTH, B_WIDTH, 2 * D_MODEL), B_WIDTH ** -0.5),
        'w_o': nrm(k[19], (DEPTH, D_MODEL, D_MODEL), D_MODEL ** -0.5),
        'norm_post_mix': 1.0 + nrm(k[20], (DEPTH, D_MODEL), 0.02),
        'norm_pre_ff': 1.0 + nrm(k[21], (DEPTH, D_MODEL), 0.02),
        'w_ff1': nrm(k[22], (DEPTH, D_MODEL, D_FF), D_MODEL ** -0.5),
        'w_ff2': nrm(k[23], (DEPTH, D_FF, D_MODEL), D_FF ** -0.5),
        'norm_post_ff': 1.0 + nrm(k[9], (DEPTH, D_MODEL), 0.02),
    }


def reference(x_prompt, x_sample, norm_pre_mix, w_in, norm_v, w_s, b_s, w_out_a,
              lam_re, lam_im, log_dt, b_re, b_im, c_re, c_im, d_skip, w_glu, w_o,
              norm_post_mix, norm_pre_ff, w_ff1, w_ff2, norm_post_ff):
    p = {
        'norm_pre_mix': norm_pre_mix, 'w_in': w_in, 'norm_v': norm_v, 'w_s': w_s, 'b_s': b_s,
        'w_out_a': w_out_a, 'lam_re': lam_re, 'lam_im': lam_im, 'log_dt': log_dt,
        'b_re': b_re, 'b_im': b_im, 'c_re': c_re, 'c_im': c_im, 'd_skip': d_skip,
        'w_glu': w_glu, 'w_o': w_o, 'norm_post_mix': norm_post_mix,
        'norm_pre_ff': norm_pre_ff, 'w_ff1': w_ff1, 'w_ff2': w_ff2,
        'norm_post_ff': norm_post_ff,
    }
    y_prompt = trunk(x_prompt, p)
    y_sample = trunk(x_sample, p)
    return (y_prompt, y_sample)
```

```cpp
#include <hip/hip_runtime.h>
#include <hip/hip_cooperative_groups.h>
#include <cstdio>
#include <cstdint>
namespace cg = cooperative_groups;

#ifndef MK_MULTI
#define MK_MULTI 0
#endif

#define LAS __attribute__((address_space(3)))
#define GAS __attribute__((address_space(1)))
typedef unsigned short bf16_t;
typedef short bf16x8 __attribute__((ext_vector_type(8)));
typedef float f32x4 __attribute__((ext_vector_type(4)));
typedef float f32x2 __attribute__((ext_vector_type(2)));
typedef unsigned u32x4 __attribute__((ext_vector_type(4)));
typedef unsigned u32x2 __attribute__((ext_vector_type(2)));

constexpr int D = 1024, FF = 4096, INW = 5120, DEPTH = 2;
constexpr int TS = 16384;
constexpr int NSLAB = 3;
constexpr int SEQ = 8192;
constexpr int SL = 32;
constexpr int NCH = TS / SL;
constexpr int KS5 = 768;
constexpr int NG = 64;
constexpr float EPS = 1e-6f;

constexpr size_t MiB = 1u << 20;
constexpr size_t WS_WT = 1 * MiB;
constexpr size_t WT_IN = 0, WT_OA = 10 * MiB, WT_GLU = 12 * MiB, WT_O = 16 * MiB, WT_FF1 = 18 * MiB, WT_FF2 = 26 * MiB, WT_LAYER = 34 * MiB;
constexpr size_t WS_S5 = 69 * MiB;
constexpr size_t S5_WST = 0, S5_TV = 16 * MiB, S5_LAYER = 64 * MiB;
constexpr size_t WS_KTAB = 197 * MiB;
constexpr size_t WS_XN = 205 * MiB;
constexpr size_t WS_UA = 237 * MiB;
constexpr size_t WS_GV = 269 * MiB;
constexpr size_t WS_UB = 301 * MiB;
constexpr size_t WS_GATE = 349 * MiB;
constexpr size_t WS_Z = 413 * MiB;
constexpr size_t WS_SB = 445 * MiB;
constexpr size_t WS_SQ = 203 * MiB;
constexpr size_t WS_XH = 478 * MiB;
constexpr size_t WS_H = 237 * MiB;
constexpr size_t WS_XB = 197 * MiB;
constexpr size_t WS_CNT = 128 * 1024;
constexpr size_t WS_GCNT = 512 * 1024;
constexpr size_t WS_PCNT = 768 * 1024;
constexpr size_t CTL_ZERO = 1024 * 1024;
constexpr size_t WS_END = 510 * MiB;

constexpr int LDS_BYTES = 139264;

typedef __bf16 bf16x2_t __attribute__((ext_vector_type(2)));
__device__ __forceinline__ unsigned cvt_pk_bf16(float lo, float hi) { const f32x2 v = {lo, hi}; const bf16x2_t b = __builtin_convertvector(v, bf16x2_t); return __builtin_bit_cast(unsigned, b); }
__device__ __forceinline__ float bf_lo(unsigned w) { return __builtin_bit_cast(float, w << 16); }
__device__ __forceinline__ float bf_hi(unsigned w) { return __builtin_bit_cast(float, w & 0xffff0000u); }
__device__ __forceinline__ float gelu_t(float v) { const float u = v * (1.0f + 0.044715f * v * v) * -2.302208198f; return v * __builtin_amdgcn_rcpf(1.0f + __builtin_amdgcn_exp2f(u)); }
__device__ __forceinline__ float sigm(float v) { return __builtin_amdgcn_rcpf(1.0f + __builtin_amdgcn_exp2f(-1.4426950409f * v)); }
__device__ __forceinline__ unsigned pack4_u8(const f32x4 v) { unsigned w = 0; w = __builtin_amdgcn_cvt_pk_u8_f32(v[0] * 255.f, 0, w); w = __builtin_amdgcn_cvt_pk_u8_f32(v[1] * 255.f, 1, w); w = __builtin_amdgcn_cvt_pk_u8_f32(v[2] * 255.f, 2, w); w = __builtin_amdgcn_cvt_pk_u8_f32(v[3] * 255.f, 3, w); return w; }
__device__ __forceinline__ f32x4 unpack4_u8(unsigned w) { return (f32x4){(float)(w & 255u), (float)((w >> 8) & 255u), (float)((w >> 16) & 255u), (float)(w >> 24)} * (1.f / 255.f); }
__device__ __forceinline__ float wave_sum(float v) {
#pragma unroll
    for (int o = 1; o < 64; o <<= 1) v += __shfl_xor(v, o);
    return v;
}

namespace pg8 {
constexpr int BM = 256, BK = 64, HALF = 128, HTB = HALF * BK * 2, STAGE_BYTES = 8 * HTB, NXCD = 8, WGM = 8;
__device__ __forceinline__ int lds_byte(int r, int c) { const int st = (r >> 4) * 2 + (c >> 5), rr = r & 15, cc = c & 31, ob = rr * 64 + cc * 2; return st * 1024 + (ob ^ (((ob >> 9) & 1) << 5)); }
__device__ __forceinline__ void stage_rc(int b, int& R, int& C) { const int st = b / 1024, sb = b % 1024, swz = sb ^ (((sb >> 9) & 1) << 5); R = (st >> 1) * 16 + swz / 64; C = (st & 1) * 32 + (swz % 64) / 2; }
__device__ __forceinline__ int perm32(int rho) { const int n = rho >> 4, i = rho & 15; return 8 * (i >> 2) + 4 * n + (i & 3); }

struct Unit { int pm, pn, pb; };
struct Gemm { const bf16_t* A; const bf16_t* Bt; int lda, ldb, K; size_t sA, sB; };

struct StaticOrder {
    int nM, nN, nwg, G, c;
    __device__ void init(int M, int N, int G_, int c_) { nM = M / BM; nN = N / BM; nwg = nM * nN; G = G_; c = c_; }
    __device__ bool next(int i, Unit& u) const {
        const long L = (long)i * G + c; if (L >= nwg) return false;
        int wgid = (int)L; { const int q = nwg / NXCD, r = nwg % NXCD, xcd = wgid % NXCD, off = wgid / NXCD; wgid = (xcd < r ? xcd * (q + 1) : r * (q + 1) + (xcd - r) * q) + off; }
        const int nig = WGM * nN, gid = wgid / nig, fm = gid * WGM, gsz = (nM - fm) < WGM ? (nM - fm) : WGM;
        u.pm = fm + ((wgid % nig) % gsz); u.pn = (wgid % nig) / gsz; u.pb = 0; return true;
    }
};
struct BatchOrder {
    int nM, nN, nB, G, c;
    __device__ void init(int M, int N, int B, int G_, int c_) { nM = M / BM; nN = N / BM; nB = B; G = G_; c = c_; }
    __device__ bool next(int i, Unit& u) const {
        const int L = i * G + c; const int per = nM * nN; if (L >= nB * per) return false;
        u.pb = L / per; const int r = L % per; u.pm = r / nN; u.pn = r % nN; return true;
    }
};

struct RangeOrder {
    int base, cnt, per, nN;
    __device__ bool next(int i, Unit& u) const {
        if (i >= cnt) return false; const int L = base + i; u.pb = L / per; const int r = L % per; u.pm = r / nN; u.pn = r % nN; return true;
    }
};

template <class Epi, class Sched>
__device__ __forceinline__ void gemm_phase(LAS unsigned char* lds, const Gemm g, const Sched& S, const Epi& E) {
    int tid_ = threadIdx.x; asm volatile("" : "+v"(tid_));
    const int tid = tid_, wid = __builtin_amdgcn_readfirstlane(tid >> 6), lane = tid & 63, wr = wid >> 2, wc = wid & 3, fr = lane & 15, fq = lane >> 4;
    const int K = g.K, nt = K / BK;
    unsigned voffA[2], voffB[2];
#pragma unroll
    for (int i = 0; i < 2; ++i) { int R, C; stage_rc(tid * 16 + i * 8192, R, C); const int Rb = Epi::PERM ? ((R & ~31) + perm32(R & 31)) : R;
        voffA[i] = (unsigned)(R * g.lda + C) * 2u; voffB[i] = (unsigned)(Rb * g.ldb + C) * 2u; }
    const size_t kstep = (size_t)(BK * 2);
    const size_t hA = (size_t)HALF * g.lda * 2, hB = (size_t)HALF * g.ldb * 2;
    const size_t tA = 2 * hA, tB = 2 * hB;
    const unsigned ldsw = (unsigned)wid * 1024u;
    const int aoff = lds_byte(wr * 64 + fr, fq * 8), boff = lds_byte(wc * 32 + fr, fq * 8);
#define PG8_SA(b, h) (((b) * 2 + (h)) * HTB)
#define PG8_SB(b, h) ((4 + (b) * 2 + (h)) * HTB)
#define PG8_STAGE(bufoff, gbase, voff) do { _Pragma("unroll") for (int _i = 0; _i < 2; ++_i) \
        __builtin_amdgcn_global_load_lds((const unsigned*)((const char*)(gbase) + (voff)[_i]), (LAS unsigned*)(lds + (bufoff) + ldsw + _i * 8192), 16, 0, 0); } while (0)
#define PG8_LDA(dst, b, h) do { _Pragma("unroll") for (int m = 0; m < 4; ++m) _Pragma("unroll") for (int k = 0; k < 2; ++k) dst[m][k] = *(const LAS bf16x8*)(lds + PG8_SA(b, h) + aoff + m * 2048 + k * 1024); } while (0)
#define PG8_LDB(dst, b, h) do { _Pragma("unroll") for (int n = 0; n < 2; ++n) _Pragma("unroll") for (int k = 0; k < 2; ++k) dst[n][k] = *(const LAS bf16x8*)(lds + PG8_SB(b, h) + boff + n * 2048 + k * 1024); } while (0)
#define PG8_MMA(ai, bj, At, Bt) do { __builtin_amdgcn_s_setprio(1); _Pragma("unroll") for (int m = 0; m < 4; ++m) _Pragma("unroll") for (int n = 0; n < 2; ++n) _Pragma("unroll") for (int k = 0; k < 2; ++k) \
        acc[ai][bj][m][n] = __builtin_amdgcn_mfma_f32_16x16x32_bf16(Bt[n][k], At[m][k], acc[ai][bj][m][n], 0, 0, 0); __builtin_amdgcn_s_setprio(0); } while (0)
#define PG8_WAIT_V(n) asm volatile("s_waitcnt vmcnt(" #n ")" ::: "memory")
#define PG8_WAIT_L(n) asm volatile("s_waitcnt lgkmcnt(" #n ")" ::: "memory")
#define PG8_BAR __builtin_amdgcn_s_barrier()
#define PG8_SCHED __builtin_amdgcn_sched_barrier(0)
    Unit cur, nxt; int ui = 0;
    if (!S.next(0, cur)) return;
    f32x4 acc[2][2][4][2];
#pragma unroll
    for (int a = 0; a < 2; ++a)
#pragma unroll
        for (int b = 0; b < 2; ++b)
#pragma unroll
            for (int m = 0; m < 4; ++m)
#pragma unroll
                for (int n = 0; n < 2; ++n) acc[a][b][m][n] = (f32x4){0.f, 0.f, 0.f, 0.f};
    bf16x8 At[4][2], B0[2][2], B1[2][2];
    const char* cA = (const char*)g.A + (size_t)cur.pb * g.sA + (size_t)cur.pm * tA; const char* cB = (const char*)g.Bt + (size_t)cur.pb * g.sB + (size_t)cur.pn * tB;
    PG8_STAGE(PG8_SB(0, 0), cB, voffB); PG8_STAGE(PG8_SB(0, 1), cB + hB, voffB); PG8_STAGE(PG8_SA(0, 0), cA, voffA); PG8_STAGE(PG8_SA(0, 1), cA + hA, voffA);
    if (wr == 1) PG8_BAR;
    PG8_WAIT_V(2); PG8_BAR;
    PG8_STAGE(PG8_SB(1, 0), cB + kstep, voffB); PG8_STAGE(PG8_SA(1, 0), cA + kstep, voffA); PG8_STAGE(PG8_SB(1, 1), cB + hB + kstep, voffB);
    PG8_WAIT_V(6); PG8_BAR;
    for (;;) {
        const bool has_next = S.next(ui + 1, nxt);
        const char* nA = has_next ? (const char*)g.A + (size_t)nxt.pb * g.sA + (size_t)nxt.pm * tA : cA;
        const char* nB = has_next ? (const char*)g.Bt + (size_t)nxt.pb * g.sB + (size_t)nxt.pn * tB : cB;
        for (int t = 0; t < nt; t += 2) {
            const bool last = (t == nt - 2);
            const char* a1 = cA + (size_t)(t + 1) * kstep;
            const char* a2 = last ? nA : cA + (size_t)(t + 2) * kstep; const char* b2 = last ? nB : cB + (size_t)(t + 2) * kstep;
            const char* a3 = a2 + kstep; const char* b3 = b2 + kstep;
            PG8_LDB(B0, 0, 0); PG8_LDB(B1, 0, 1); PG8_SCHED; PG8_LDA(At, 0, 0); PG8_STAGE(PG8_SA(1, 1), a1 + hA, voffA);
            PG8_WAIT_V(8); PG8_WAIT_L(0); PG8_BAR; PG8_MMA(0, 0, At, B0); PG8_MMA(0, 1, At, B1); PG8_BAR; PG8_SCHED;
            PG8_LDA(At, 0, 1); PG8_STAGE(PG8_SB(0, 0), b2, voffB); PG8_STAGE(PG8_SB(0, 1), b2 + hB, voffB); PG8_STAGE(PG8_SA(0, 0), a2, voffA);
            PG8_WAIT_V(8); PG8_WAIT_L(0); PG8_BAR; PG8_MMA(1, 0, At, B0); PG8_MMA(1, 1, At, B1); PG8_BAR; PG8_SCHED;
            PG8_LDB(B0, 1, 0); PG8_LDB(B1, 1, 1); PG8_SCHED; PG8_LDA(At, 1, 0); PG8_STAGE(PG8_SA(0, 1), a2 + hA, voffA);
            PG8_WAIT_V(8); PG8_WAIT_L(0); PG8_BAR; PG8_MMA(0, 0, At, B0); PG8_MMA(0, 1, At, B1); PG8_BAR; PG8_SCHED;
            PG8_LDA(At, 1, 1); PG8_STAGE(PG8_SB(1, 0), b3, voffB); PG8_STAGE(PG8_SB(1, 1), b3 + hB, voffB); PG8_STAGE(PG8_SA(1, 0), a3, voffA);
            PG8_WAIT_V(8); PG8_WAIT_L(0); PG8_BAR; PG8_MMA(1, 0, At, B0); PG8_MMA(1, 1, At, B1); PG8_BAR; PG8_SCHED;
        }
        if (wr == 0) PG8_BAR;
        if constexpr (!Epi::AFTER_DRAIN) E(acc, cur, wr, wc, fr, fq);
        if (!has_next) break;
#pragma unroll
        for (int a = 0; a < 2; ++a)
#pragma unroll
            for (int b = 0; b < 2; ++b)
#pragma unroll
                for (int m = 0; m < 4; ++m)
#pragma unroll
                    for (int n = 0; n < 2; ++n) acc[a][b][m][n] = (f32x4){0.f, 0.f, 0.f, 0.f};
        cur = nxt; cA = nA; cB = nB; ++ui;
        if (wr == 1) PG8_BAR;
    }
    PG8_WAIT_V(0);
    PG8_BAR;
    if constexpr (Epi::AFTER_DRAIN) E.fused(acc, cur, wr, wc, fr, fq, lds, wid, lane);
#undef PG8_SA
#undef PG8_SB
#undef PG8_STAGE
#undef PG8_LDA
#undef PG8_LDB
#undef PG8_MMA
#undef PG8_WAIT_V
#undef PG8_WAIT_L
#undef PG8_BAR
#undef PG8_SCHED
}

typedef f32x4 Acc[2][2][4][2];
__device__ __forceinline__ u32x4 pack8(const f32x4 a, const f32x4 b) { u32x4 w; w.x = cvt_pk_bf16(a[0], a[1]); w.y = cvt_pk_bf16(a[2], a[3]); w.z = cvt_pk_bf16(b[0], b[1]); w.w = cvt_pk_bf16(b[2], b[3]); return w; }

struct EpiIn {
    static constexpr bool PERM = true, AFTER_DRAIN = false;
    bf16_t *UA, *GV, *UB, *GATE; float* VSQ;
    __device__ __forceinline__ void operator()(const Acc& acc, const Unit& u, int wr, int wc, int fr, int fq) const {
        const int pn = u.pn, row0 = u.pm * 256 + wr * 64 + fr, cl = wc * 32 + 8 * fq;
        if (pn < 8) {
            bf16_t* O = (pn < 4) ? UA : GV; const int cb = (pn & 3) * 256 + cl;
#pragma unroll
            for (int ai = 0; ai < 2; ++ai)
#pragma unroll
                for (int m = 0; m < 4; ++m) { const int row = row0 + ai * 128 + m * 16; float ss = 0.f;
#pragma unroll
                    for (int bj = 0; bj < 2; ++bj) { f32x4 v0 = acc[ai][bj][m][0], v1 = acc[ai][bj][m][1];
#pragma unroll
                        for (int j = 0; j < 4; ++j) { v0[j] = gelu_t(v0[j]); v1[j] = gelu_t(v1[j]); ss += v0[j] * v0[j] + v1[j] * v1[j]; }
                        *(u32x4*)(O + (size_t)row * D + cb + bj * 128) = pack8(v0, v1); }
                    if (pn >= 4) { ss += __shfl_xor(ss, 16); ss += __shfl_xor(ss, 32); if (fq == 0) VSQ[row * 16 + (pn - 4) * 4 + wc] = ss; } }
        } else if (pn < 12) {
#pragma unroll
            for (int ai = 0; ai < 2; ++ai)
#pragma unroll
                for (int m = 0; m < 4; ++m) { const int row = row0 + ai * 128 + m * 16, chunk = row >> 5, j = row & 31;
#pragma unroll
                    for (int bj = 0; bj < 2; ++bj) { const int cb = (pn - 8) * 256 + bj * 128 + cl, g = cb >> 4, h0 = cb & 15;
                        *(u32x4*)(UB + ((size_t)(g * NCH + chunk) * KS5 + j * 16 + h0)) = pack8(acc[ai][bj][m][0], acc[ai][bj][m][1]); } }
        } else {
            const int cb = (pn - 12) * 256 + cl;
#pragma unroll
            for (int ai = 0; ai < 2; ++ai)
#pragma unroll
                for (int m = 0; m < 4; ++m) { const int row = row0 + ai * 128 + m * 16;
#pragma unroll
                    for (int bj = 0; bj < 2; ++bj) { f32x4 v0 = acc[ai][bj][m][0], v1 = acc[ai][bj][m][1];
#pragma unroll
                        for (int j = 0; j < 4; ++j) { v0[j] = sigm(v0[j]); v1[j] = sigm(v1[j]); }
                        u32x2 o; o.x = pack4_u8(v0); o.y = pack4_u8(v1); *(u32x2*)((unsigned char*)GATE + (size_t)row * 2048 + cb + bj * 128) = o; } }
        }
    }
};
struct EpiState {
    static constexpr bool PERM = false, AFTER_DRAIN = false;
    float* SB;
    __device__ __forceinline__ void operator()(const Acc& acc, const Unit& u, int wr, int wc, int fr, int fq) const {
        GAS float* rp = (GAS float*)(SB + ((size_t)u.pb * NCH + u.pm * 256 + wr * 64 + fr) * 256 + wc * 32 + 4 * fq);
#pragma unroll
        for (int ai = 0; ai < 2; ++ai) {
#pragma unroll
            for (int m = 0; m < 4; ++m) {
                asm volatile("" : "+v"(rp));
#pragma unroll
                for (int bj = 0; bj < 2; ++bj)
#pragma unroll
                    for (int n = 0; n < 2; ++n) *(GAS f32x4*)(rp + bj * 128 + n * 16) = acc[ai][bj][m][n];
                rp += 16 * 256; }
            rp += 64 * 256; }
    }
};
struct EpiS5 {
    static constexpr bool PERM = true, AFTER_DRAIN = false;
    bf16_t* Z;
    __device__ __forceinline__ void operator()(const Acc& acc, const Unit& u, int wr, int wc, int fr, int fq) const {
        const int row0 = u.pm * 256 + wr * 64 + fr, cl = u.pn * 256 + wc * 32 + 8 * fq;
#pragma unroll
        for (int ai = 0; ai < 2; ++ai)
#pragma unroll
            for (int m = 0; m < 4; ++m) { const int chunk = row0 + ai * 128 + m * 16;
#pragma unroll
                for (int bj = 0; bj < 2; ++bj) { const int n = cl + bj * 128, i = n >> 4, h0 = n & 15; f32x4 v0 = acc[ai][bj][m][0], v1 = acc[ai][bj][m][1];
#pragma unroll
                    for (int j = 0; j < 4; ++j) { v0[j] = gelu_t(v0[j]); v1[j] = gelu_t(v1[j]); }
                    *(u32x4*)(Z + (size_t)(chunk * SL + i) * D + u.pb * 16 + h0) = pack8(v0, v1); } }
    }
};
struct EpiGlu {
    static constexpr bool PERM = true, AFTER_DRAIN = false;
    const bf16_t* GATE; const bf16_t* MA; bf16_t* MI;
    __device__ __forceinline__ void operator()(const Acc& acc, const Unit& u, int wr, int wc, int fr, int fq) const {
        const int row0 = u.pm * 256 + wr * 64 + fr, j0 = u.pn * 128 + wc * 32 + 8 * fq;
#pragma unroll
        for (int ai = 0; ai < 2; ++ai)
#pragma unroll
            for (int m = 0; m < 4; ++m) { const int row = row0 + ai * 128 + m * 16;
                const u32x2 g8 = *(const u32x2*)((const unsigned char*)GATE + (size_t)row * 2048 + 1024 + j0); const f32x4 ga = unpack4_u8(g8.x), gb = unpack4_u8(g8.y); const u32x4 mw = *(const u32x4*)(MA + (size_t)row * D + j0);
                f32x4 a0 = acc[ai][0][m][0], a1 = acc[ai][0][m][1]; const f32x4 b0 = acc[ai][1][m][0], b1 = acc[ai][1][m][1];
                a0[0] = a0[0] * sigm(b0[0]) * ga[0] + bf_lo(mw.x); a0[1] = a0[1] * sigm(b0[1]) * ga[1] + bf_hi(mw.x); a0[2] = a0[2] * sigm(b0[2]) * ga[2] + bf_lo(mw.y); a0[3] = a0[3] * sigm(b0[3]) * ga[3] + bf_hi(mw.y);
                a1[0] = a1[0] * sigm(b1[0]) * gb[0] + bf_lo(mw.z); a1[1] = a1[1] * sigm(b1[1]) * gb[1] + bf_hi(mw.z); a1[2] = a1[2] * sigm(b1[2]) * gb[2] + bf_lo(mw.w); a1[3] = a1[3] * sigm(b1[3]) * gb[3] + bf_hi(mw.w);
                *(u32x4*)(MI + (size_t)row * D + j0) = pack8(a0, a1); }
    }
};
struct EpiMixA {
    static constexpr bool PERM = true, AFTER_DRAIN = false;
    const bf16_t* GATE; bf16_t* MA;
    __device__ __forceinline__ void operator()(const Acc& acc, const Unit& u, int wr, int wc, int fr, int fq) const {
        const int row0 = u.pm * 256 + wr * 64 + fr, cl = u.pn * 256 + wc * 32 + 8 * fq;
#pragma unroll
        for (int ai = 0; ai < 2; ++ai)
#pragma unroll
            for (int m = 0; m < 4; ++m) { const int row = row0 + ai * 128 + m * 16;
#pragma unroll
                for (int bj = 0; bj < 2; ++bj) { const int c = cl + bj * 128; f32x4 v0 = acc[ai][bj][m][0], v1 = acc[ai][bj][m][1];
                    const u32x2 g8 = *(const u32x2*)((const unsigned char*)GATE + (size_t)row * 2048 + c);
                    v0 = v0 * unpack4_u8(g8.x); v1 = v1 * unpack4_u8(g8.y);
                    *(u32x4*)(MA + (size_t)row * D + c) = pack8(v0, v1); } }
    }
};
struct EpiSq {
    static constexpr bool PERM = true, AFTER_DRAIN = false;
    bf16_t* O; float* SQ;
    __device__ __forceinline__ void operator()(const Acc& acc, const Unit& u, int wr, int wc, int fr, int fq) const {
        const int row0 = u.pm * 256 + wr * 64 + fr, cl = u.pn * 256 + wc * 32 + 8 * fq;
#pragma unroll
        for (int ai = 0; ai < 2; ++ai)
#pragma unroll
            for (int m = 0; m < 4; ++m) { const int row = row0 + ai * 128 + m * 16; float ss = 0.f;
#pragma unroll
                for (int bj = 0; bj < 2; ++bj) { const f32x4 v0 = acc[ai][bj][m][0], v1 = acc[ai][bj][m][1];
#pragma unroll
                    for (int j = 0; j < 4; ++j) ss += v0[j] * v0[j] + v1[j] * v1[j];
                    *(u32x4*)(O + (size_t)row * D + cl + bj * 128) = pack8(v0, v1); }
                ss += __shfl_xor(ss, 16); ss += __shfl_xor(ss, 32); if (fq == 0) SQ[row * 16 + u.pn * 4 + wc] = ss; }
    }
};
struct EpiRelu2 {
    static constexpr bool PERM = true, AFTER_DRAIN = false;
    bf16_t* H;
    __device__ __forceinline__ void operator()(const Acc& acc, const Unit& u, int wr, int wc, int fr, int fq) const {
        const int row0 = u.pm * 256 + wr * 64 + fr, cl = u.pn * 256 + wc * 32 + 8 * fq;
#pragma unroll
        for (int ai = 0; ai < 2; ++ai)
#pragma unroll
            for (int m = 0; m < 4; ++m) { const int row = row0 + ai * 128 + m * 16;
#pragma unroll
                for (int bj = 0; bj < 2; ++bj) { f32x4 v0 = acc[ai][bj][m][0], v1 = acc[ai][bj][m][1];
#pragma unroll
                    for (int j = 0; j < 4; ++j) { const float a = fmaxf(v0[j], 0.f), b = fmaxf(v1[j], 0.f); v0[j] = a * a; v1[j] = b * b; }
                    *(u32x4*)(H + (size_t)row * FF + cl + bj * 128) = pack8(v0, v1); } }
    }
};

struct EpiRmsRes {
    static constexpr bool PERM = true, AFTER_DRAIN = true;
    const float* xin32; const bf16_t* xin16; float* xout32; bf16_t* xout16; const float* gpost; const float* gnext; bf16_t* XN; float* xbuf; unsigned* cnt;
    __device__ __forceinline__ void stats(const float (&ss)[2][4], float (&rs)[2][4], const Unit& u, int wr, int wc, int fr, int fq, LAS unsigned char* lds, int wid, int lane, int bank) const {
        LAS float* P = (LAS float*)lds; LAS float* S = P + 1024; const int tid = wid * 64 + lane;
#pragma unroll
        for (int ai = 0; ai < 2; ++ai)
#pragma unroll
            for (int m = 0; m < 4; ++m) { float v = ss[ai][m]; v += __shfl_xor(v, 16); v += __shfl_xor(v, 32); if (fq == 0) P[(ai * 128 + wr * 64 + m * 16 + fr) * 4 + wc] = v; }
        __syncthreads();
        float* xb = xbuf + (size_t)bank * 64 * 256 * 4 + (size_t)u.pm * 256 * 4; unsigned* c = cnt + (size_t)bank * 64 * 64 + u.pm * 64;
        if (tid < 256) { const float v = (P[tid * 4 + 0] + P[tid * 4 + 1]) + (P[tid * 4 + 2] + P[tid * 4 + 3]); __hip_atomic_store(xb + tid * 4 + u.pn, v, __ATOMIC_RELAXED, __HIP_MEMORY_SCOPE_AGENT); }
        asm volatile("s_waitcnt vmcnt(0)" ::: "memory");
        if (wid < 4 && lane == 0) __hip_atomic_fetch_add(c, 1u, __ATOMIC_RELAXED, __HIP_MEMORY_SCOPE_AGENT);
        if (wid == 0) { unsigned sp = 0; while (__hip_atomic_load(c, __ATOMIC_RELAXED, __HIP_MEMORY_SCOPE_AGENT) < 16u) { __builtin_amdgcn_s_sleep(1); if (++sp > (1u << 20)) break; }
            __builtin_amdgcn_fence(__ATOMIC_ACQUIRE, "agent"); asm volatile("s_waitcnt vmcnt(0)" ::: "memory"); }
        __syncthreads();
        if (tid < 256) { const float t = (__hip_atomic_load(xb + tid * 4 + 0, __ATOMIC_RELAXED, __HIP_MEMORY_SCOPE_AGENT) + __hip_atomic_load(xb + tid * 4 + 1, __ATOMIC_RELAXED, __HIP_MEMORY_SCOPE_AGENT))
                                     + (__hip_atomic_load(xb + tid * 4 + 2, __ATOMIC_RELAXED, __HIP_MEMORY_SCOPE_AGENT) + __hip_atomic_load(xb + tid * 4 + 3, __ATOMIC_RELAXED, __HIP_MEMORY_SCOPE_AGENT));
            S[tid] = rsqrtf(t * (1.f / D) + EPS); }
        __syncthreads();
#pragma unroll
        for (int ai = 0; ai < 2; ++ai)
#pragma unroll
            for (int m = 0; m < 4; ++m) rs[ai][m] = S[ai * 128 + wr * 64 + m * 16 + fr];
        __syncthreads();
    }
    __device__ __forceinline__ void fused(Acc& acc, const Unit& u, int wr, int wc, int fr, int fq, LAS unsigned char* lds, int wid, int lane) const {
        float ss[2][4], rs[2][4];
#pragma unroll
        for (int ai = 0; ai < 2; ++ai)
#pragma unroll
            for (int m = 0; m < 4; ++m) { float q = 0.f;
#pragma unroll
                for (int bj = 0; bj < 2; ++bj)
#pragma unroll
                    for (int n = 0; n < 2; ++n) { const f32x4 v = acc[ai][bj][m][n]; q += (v[0] * v[0] + v[1] * v[1]) + (v[2] * v[2] + v[3] * v[3]); }
                ss[ai][m] = q; }
        stats(ss, rs, u, wr, wc, fr, fq, lds, wid, lane, 0);
        const int row0 = u.pm * 256 + wr * 64 + fr, col0 = u.pn * 256 + wc * 32 + 8 * fq;
#pragma unroll
        for (int ai = 0; ai < 2; ++ai)
#pragma unroll
            for (int m = 0; m < 4; ++m) { const size_t ro = (size_t)(row0 + ai * 128 + m * 16) * D + col0; float q = 0.f;
#pragma unroll
                for (int bj = 0; bj < 2; ++bj) { const int co = bj * 128; f32x4 x0, x1;
                    if (xin32) { x0 = *(const f32x4*)(xin32 + ro + co); x1 = *(const f32x4*)(xin32 + ro + co + 4); }
                    else { const u32x4 w = *(const u32x4*)(xin16 + ro + co); x0 = (f32x4){bf_lo(w.x), bf_hi(w.x), bf_lo(w.y), bf_hi(w.y)}; x1 = (f32x4){bf_lo(w.z), bf_hi(w.z), bf_lo(w.w), bf_hi(w.w)}; }
                    const f32x4 g0 = *(const f32x4*)(gpost + col0 + co), g1 = *(const f32x4*)(gpost + col0 + co + 4);
                    const f32x4 v0 = x0 + acc[ai][bj][m][0] * rs[ai][m] * g0, v1 = x1 + acc[ai][bj][m][1] * rs[ai][m] * g1; acc[ai][bj][m][0] = v0; acc[ai][bj][m][1] = v1;
                    if (xout32) { *(f32x4*)(xout32 + ro + co) = v0; *(f32x4*)(xout32 + ro + co + 4) = v1; } else *(u32x4*)(xout16 + ro + co) = pack8(v0, v1);
                    q += ((v0[0] * v0[0] + v0[1] * v0[1]) + (v0[2] * v0[2] + v0[3] * v0[3])) + ((v1[0] * v1[0] + v1[1] * v1[1]) + (v1[2] * v1[2] + v1[3] * v1[3])); }
                ss[ai][m] = q; }
        if (gnext) {
            stats(ss, rs, u, wr, wc, fr, fq, lds, wid, lane, 1);
#pragma unroll
            for (int ai = 0; ai < 2; ++ai)
#pragma unroll
                for (int m = 0; m < 4; ++m) { const size_t ro = (size_t)(row0 + ai * 128 + m * 16) * D + col0;
#pragma unroll
                    for (int bj = 0; bj < 2; ++bj) { const int co = bj * 128; const f32x4 g0 = *(const f32x4*)(gnext + col0 + co), g1 = *(const f32x4*)(gnext + col0 + co + 4);
                        *(u32x4*)(XN + ro + co) = pack8(acc[ai][bj][m][0] * rs[ai][m] * g0, acc[ai][bj][m][1] * rs[ai][m] * g1); } }
        }
    }
};
}

struct Args { const float* in[23]; float* out; unsigned char* ws; int ph_lo, ph_hi; };
enum { I_XP = 0, I_XS, I_NPM, I_WIN, I_NV, I_WS, I_BS, I_WOA, I_LRE, I_LIM, I_LDT, I_BRE, I_BIM, I_CRE, I_CIM, I_DSK, I_WGLU, I_WO, I_NPOM, I_NPF, I_WFF1, I_WFF2, I_NPOF };

struct Frame { LAS unsigned char* lds; int tid, lane, wave, vcu, G, bx; };

__device__ __forceinline__ void transpose_item(const float* W, int K, int N, bf16_t* WT, bool glu, LAS float* scr, int item, int lane) {
    const int nblk = N / 32, kb = item / nblk, nb = item % nblk, k0 = 64 * kb, n0 = 32 * nb;
#pragma unroll 8
    for (int i = 0; i < 32; ++i) { const int kk = 2 * i + (lane >> 5); scr[kk * 33 + (lane & 31)] = W[(size_t)(k0 + kk) * N + n0 + (lane & 31)]; }
    asm volatile("s_waitcnt lgkmcnt(0)" ::: "memory");
    const int c = lane & 7;
#pragma unroll
    for (int j = 0; j < 4; ++j) { const int n = (lane >> 3) + 8 * j; const LAS float* s = scr + (8 * c) * 33 + n;
        u32x4 o; o.x = cvt_pk_bf16(s[0 * 33], s[1 * 33]); o.y = cvt_pk_bf16(s[2 * 33], s[3 * 33]); o.z = cvt_pk_bf16(s[4 * 33], s[5 * 33]); o.w = cvt_pk_bf16(s[6 * 33], s[7 * 33]);
        int nn = n0 + n; if (glu) { const int sj = nn >> 10, j = nn & 1023; nn = (j >> 7) * 256 + sj * 128 + (j & 127); }
        *(u32x4*)(WT + (size_t)nn * K + k0 + 8 * c) = o; }
    asm volatile("s_waitcnt lgkmcnt(0)" ::: "memory");
}

__device__ __forceinline__ const float* x_in_row(const Args& a, int slab, int r) {
    return (slab == 0 ? a.in[I_XP] : a.in[I_XS] + (size_t)(slab - 1) * TS * D) + (size_t)r * D;
}
__device__ __forceinline__ void enorm0(const Frame& F, const Args& a, int slab, bf16_t* XN) {
    const int gw = F.vcu * 8 + F.wave, NGW = F.G * 8; const float* g = a.in[I_NPM];
    for (int r = gw; r < TS; r += NGW) {
        const f32x4* xr = (const f32x4*)x_in_row(a, slab, r) + F.lane; f32x4 v[4]; float s = 0.f;
#pragma unroll
        for (int j = 0; j < 4; ++j) { v[j] = xr[64 * j]; s += (v[j].x * v[j].x + v[j].y * v[j].y) + (v[j].z * v[j].z + v[j].w * v[j].w); }
        const float rs = rsqrtf(wave_sum(s) * (1.f / D) + EPS);
        u32x2* o = (u32x2*)(XN + (size_t)r * D) + F.lane;
#pragma unroll
        for (int j = 0; j < 4; ++j) { const f32x4 gg = ((const f32x4*)g)[F.lane + 64 * j]; u32x2 w; w.x = cvt_pk_bf16(v[j].x * rs * gg.x, v[j].y * rs * gg.y); w.y = cvt_pk_bf16(v[j].z * rs * gg.z, v[j].w * rs * gg.w); o[64 * j] = w; }
    }
}
__device__ __forceinline__ void resnorm(const Frame& F, const float* xin, const bf16_t* Y, const float* SQ, const float* gpost, float* xout, const float* gnext, bf16_t* XN) {
    const int gw = F.vcu * 8 + F.wave, NGW = F.G * 8;
    for (int r = gw; r < TS; r += NGW) {
        const f32x4 q0 = ((const f32x4*)(SQ + r * 16))[0], q1 = ((const f32x4*)(SQ + r * 16))[1], q2 = ((const f32x4*)(SQ + r * 16))[2], q3 = ((const f32x4*)(SQ + r * 16))[3];
        const float ssq = ((q0.x + q0.y) + (q0.z + q0.w)) + ((q1.x + q1.y) + (q1.z + q1.w)) + ((q2.x + q2.y) + (q2.z + q2.w)) + ((q3.x + q3.y) + (q3.z + q3.w));
        const float ry = rsqrtf(ssq * (1.f / D) + EPS);
        const f32x4* xr = (const f32x4*)(xin + (size_t)r * D) + F.lane; const u32x2* yr = (const u32x2*)(Y + (size_t)r * D) + F.lane;
        f32x4 v[4]; float s = 0.f;
#pragma unroll
        for (int j = 0; j < 4; ++j) { const f32x4 x = xr[64 * j]; const u32x2 y = yr[64 * j]; const f32x4 gg = ((const f32x4*)gpost)[F.lane + 64 * j];
            v[j].x = x.x + bf_lo(y.x) * ry * gg.x; v[j].y = x.y + bf_hi(y.x) * ry * gg.y; v[j].z = x.z + bf_lo(y.y) * ry * gg.z; v[j].w = x.w + bf_hi(y.y) * ry * gg.w;
            s += (v[j].x * v[j].x + v[j].y * v[j].y) + (v[j].z * v[j].z + v[j].w * v[j].w); }
        f32x4* xo = (f32x4*)(xout + (size_t)r * D) + F.lane;
#pragma unroll
        for (int j = 0; j < 4; ++j) xo[64 * j] = v[j];
        if (gnext) { const float rs = rsqrtf(wave_sum(s) * (1.f / D) + EPS); u32x2* o = (u32x2*)(XN + (size_t)r * D) + F.lane;
#pragma unroll
            for (int j = 0; j < 4; ++j) { const f32x4 gg = ((const f32x4*)gnext)[F.lane + 64 * j]; u32x2 w; w.x = cvt_pk_bf16(v[j].x * rs * gg.x, v[j].y * rs * gg.y); w.y = cvt_pk_bf16(v[j].z * rs * gg.z, v[j].w * rs * gg.w); o[64 * j] = w; } }
    }
}

struct Cplx { float re, im; };
__device__ __forceinline__ Cplx cmul(Cplx a, Cplx b) { return Cplx{a.re * b.re - a.im * b.im, a.re * b.im + a.im * b.re}; }
__device__ __forceinline__ Cplx apow(float lr, float li, float dt, float e) { const float m = expf(lr * dt * e); float sn, cs; sincosf(li * dt * e, &sn, &cs); return Cplx{m * cs, m * sn}; }
__device__ __forceinline__ Cplx zoh_coef(float lr, float li, float dt) { const Cplx a = apow(lr, li, dt, 1.f); const float xr = a.re - 1.f, xi = a.im, den = 1.f / (lr * lr + li * li); return Cplx{(xr * lr + xi * li) * den, (xi * lr - xr * li) * den}; }

__device__ __forceinline__ void prologue_a(const Frame& F, const Args& a) {
    LAS float* scr = (LAS float*)(F.lds + F.wave * 16384);
    const int gw = F.vcu * 8 + F.wave, NGW = F.G * 8;
    constexpr int I_IN = (D / 64) * (INW / 32), I_SQ = (D / 64) * (D / 32), I_GLU = (D / 64) * (2048 / 32), I_F1 = (D / 64) * (FF / 32), I_F2 = (FF / 64) * (D / 32);
    constexpr int PER_L = I_IN + 2 * I_SQ + I_GLU + I_F1 + I_F2;
    for (int it = gw; it < DEPTH * PER_L; it += NGW) {
        const int l = it / PER_L; int r = it % PER_L; unsigned char* wt = a.ws + WS_WT + (size_t)l * WT_LAYER;
        if (r < I_IN) { transpose_item(a.in[I_WIN] + (size_t)l * D * INW, D, INW, (bf16_t*)(wt + WT_IN), false, scr, r, F.lane); continue; } r -= I_IN;
        if (r < I_SQ) { transpose_item(a.in[I_WOA] + (size_t)l * D * D, D, D, (bf16_t*)(wt + WT_OA), false, scr, r, F.lane); continue; } r -= I_SQ;
        if (r < I_GLU) { transpose_item(a.in[I_WGLU] + (size_t)l * D * 2048, D, 2048, (bf16_t*)(wt + WT_GLU), true, scr, r, F.lane); continue; } r -= I_GLU;
        if (r < I_SQ) { transpose_item(a.in[I_WO] + (size_t)l * D * D, D, D, (bf16_t*)(wt + WT_O), false, scr, r, F.lane); continue; } r -= I_SQ;
        if (r < I_F1) { transpose_item(a.in[I_WFF1] + (size_t)l * D * FF, D, FF, (bf16_t*)(wt + WT_FF1), false, scr, r, F.lane); continue; } r -= I_F1;
        transpose_item(a.in[I_WFF2] + (size_t)l * FF * D, FF, D, (bf16_t*)(wt + WT_FF2), false, scr, r, F.lane);
    }
    float* KT = (float*)(a.ws + WS_KTAB);
    for (int it = gw; it < DEPTH * NG * 2 * SL; it += NGW) {
        const int tau = it % SL, d = (it / SL) % 2, g = (it / (2 * SL)) % NG, l = it / (2 * SL * NG);
        const int ldg = (l * 2 + d) * NG + g, p = F.lane;
        const float lr = a.in[I_LRE][ldg * 64 + p], li = a.in[I_LIM][ldg * 64 + p], dt = expf(a.in[I_LDT][ldg]);
        const Cplx w = cmul(apow(lr, li, dt, (float)tau), zoh_coef(lr, li, dt));
        const int ho = F.lane >> 2, hi0 = (F.lane & 3) * 4;
        f32x4 o = {0.f, 0.f, 0.f, 0.f};
#pragma unroll 8
        for (int pp = 0; pp < 64; ++pp) {
            const float wr_ = __shfl(w.re, pp), wi_ = __shfl(w.im, pp);
            const float cr = a.in[I_CRE][((size_t)ldg * 16 + ho) * 64 + pp], ci = a.in[I_CIM][((size_t)ldg * 16 + ho) * 64 + pp];
            const f32x4 br = *(const f32x4*)(a.in[I_BRE] + ((size_t)ldg * 64 + pp) * 16 + hi0), bi = *(const f32x4*)(a.in[I_BIM] + ((size_t)ldg * 64 + pp) * 16 + hi0);
            const float xr = cr * wr_ - ci * wi_, xi = cr * wi_ + ci * wr_;
            o.x += xr * br.x - xi * bi.x; o.y += xr * br.y - xi * bi.y; o.z += xr * br.z - xi * bi.z; o.w += xr * br.w - xi * bi.w;
        }
        *(f32x4*)(KT + (size_t)it * 256 + ho * 16 + hi0) = o;
    }
    enorm0(F, a, 0, (bf16_t*)(a.ws + WS_XN));
}
__device__ __forceinline__ void prologue_b(const Frame& F, const Args& a) {
    const int gt = (F.vcu * 8 + F.wave) * 64 + F.lane, NGT = F.G * 512;
    const float* KT = (const float*)(a.ws + WS_KTAB);
    for (int it = gt; it < DEPTH * NG * 2 * 64 * SL; it += NGT) {
        const int j = it % SL, p = (it / SL) % 64, d = (it / (SL * 64)) % 2, g = (it / (SL * 128)) % NG, l = it / (SL * 128 * NG);
        const int ldg = (l * 2 + d) * NG + g;
        const float lr = a.in[I_LRE][ldg * 64 + p], li = a.in[I_LIM][ldg * 64 + p], dt = expf(a.in[I_LDT][ldg]);
        const Cplx z = cmul(apow(lr, li, dt, d == 0 ? (float)(SL - 1 - j) : (float)j), zoh_coef(lr, li, dt));
        bf16_t* W = (bf16_t*)(a.ws + WS_S5 + (size_t)l * S5_LAYER + S5_WST) + ((size_t)g * 256 + d * 128 + p) * 512 + j * 16;
        const float* br = a.in[I_BRE] + ((size_t)ldg * 64 + p) * 16; const float* bi = a.in[I_BIM] + ((size_t)ldg * 64 + p) * 16;
#pragma unroll
        for (int h8 = 0; h8 < 2; ++h8) { float re[8], im[8];
#pragma unroll
            for (int k = 0; k < 8; ++k) { const float b_r = br[h8 * 8 + k], b_i = bi[h8 * 8 + k]; re[k] = z.re * b_r - z.im * b_i; im[k] = z.re * b_i + z.im * b_r; }
            u32x4 o; o.x = cvt_pk_bf16(re[0], re[1]); o.y = cvt_pk_bf16(re[2], re[3]); o.z = cvt_pk_bf16(re[4], re[5]); o.w = cvt_pk_bf16(re[6], re[7]);
            *(u32x4*)(W + h8 * 8) = o;
            o.x = cvt_pk_bf16(im[0], im[1]); o.y = cvt_pk_bf16(im[2], im[3]); o.z = cvt_pk_bf16(im[4], im[5]); o.w = cvt_pk_bf16(im[6], im[7]);
            *(u32x4*)(W + (size_t)64 * 512 + h8 * 8) = o; }
    }
    for (int it = gt; it < DEPTH * NG * 2 * SL * 64; it += NGT) {
        const int p = it % 64, i = (it / 64) % SL, d = (it / (64 * SL)) % 2, g = (it / (128 * SL)) % NG, l = it / (128 * SL * NG);
        const int ldg = (l * 2 + d) * NG + g;
        const float lr = a.in[I_LRE][ldg * 64 + p], li = a.in[I_LIM][ldg * 64 + p], dt = expf(a.in[I_LDT][ldg]);
        const Cplx z = apow(lr, li, dt, d == 0 ? (float)(i + 1) : (float)(SL - i));
        bf16_t* T = (bf16_t*)(a.ws + WS_S5 + (size_t)l * S5_LAYER + S5_TV) + ((size_t)g * 512 + i * 16) * KS5 + 512 + d * 128 + p;
#pragma unroll 4
        for (int ho = 0; ho < 16; ++ho) { const float cr = a.in[I_CRE][((size_t)ldg * 16 + ho) * 64 + p], ci = a.in[I_CIM][((size_t)ldg * 16 + ho) * 64 + p];
            const unsigned w = cvt_pk_bf16(cr * z.re - ci * z.im, -(cr * z.im + ci * z.re));
            T[(size_t)ho * KS5] = (bf16_t)(w & 0xffffu); T[(size_t)ho * KS5 + 64] = (bf16_t)(w >> 16); }
    }
    for (int it = gt; it < DEPTH * NG * 512 * 64; it += NGT) {
        const int kb = it % 64, n = (it / 64) % 512, g = (it / (64 * 512)) % NG, l = it / (64 * 512 * NG);
        const int j = kb >> 1, hi0 = (kb & 1) * 8, i = n >> 4, ho = n & 15;
        f32x4 v0 = {0.f, 0.f, 0.f, 0.f}, v1 = v0;
        if (j <= i) { const float* k = KT + ((((size_t)(l * NG + g) * 2 + 0) * SL + (i - j)) * 16 + ho) * 16 + hi0; v0 += *(const f32x4*)k; v1 += *(const f32x4*)(k + 4); }
        if (j >= i) { const float* k = KT + ((((size_t)(l * NG + g) * 2 + 1) * SL + (j - i)) * 16 + ho) * 16 + hi0; v0 += *(const f32x4*)k; v1 += *(const f32x4*)(k + 4); }
        if (j == i && (ho >> 3) == (kb & 1)) { const float dk = a.in[I_DSK][l * D + g * 16 + ho]; const int e = ho & 7;
            if (e < 4) v0[e] += dk; else v1[e - 4] += dk; }
        *(u32x4*)((bf16_t*)(a.ws + WS_S5 + (size_t)l * S5_LAYER + S5_TV) + ((size_t)g * 512 + n) * KS5 + j * 16 + hi0) = pg8::pack8(v0, v1);
    }
}

__device__ __forceinline__ void gating_phase(const Frame& F, const Args& a, int l, bf16_t* UA, const bf16_t* GV, const float* VSQ) {
    constexpr int PITCH = 136;
    LAS bf16_t* Wl = (LAS bf16_t*)F.lds; LAS bf16_t* Vt = Wl + 128 * PITCH; LAS float* rq = (LAS float*)(Vt + 128 * PITCH);
    const int fr = F.lane & 15, fq = F.lane >> 4, p0 = (F.wave >> 1) * 32, c0 = (F.wave & 1) * 64;
    const bool bal = (F.G == 256); const int it0 = bal ? (F.vcu < 128 ? F.vcu * 3 : 384 + (F.vcu - 128) * 5) : F.vcu, itn = bal ? (F.vcu < 128 ? 3 : 5) : ((TS / 128) * 8 - F.vcu + F.G - 1) / F.G, its = bal ? 1 : F.G;
    for (int ii = 0; ii < itn; ++ii) { const int it = it0 + ii * its;
        const int n = it >> 3, g = it & 7;
        if (F.tid < 128) { const float* q = VSQ + (size_t)(n * 128 + F.tid) * 16; float s = 0.f;
#pragma unroll
            for (int k = 0; k < 16; ++k) s += q[k];
            rq[F.tid] = rsqrtf(s * (1.f / D) + EPS); }
        __syncthreads();
        const float* Ws = a.in[I_WS] + ((size_t)l * 8 + g) * 128 * 128;
#pragma unroll
        for (int k = 0; k < 8; ++k) { const int idx = k * 512 + F.tid, p = idx >> 5, q4 = (idx & 31) * 4; const f32x4 w = *(const f32x4*)(Ws + p * 128 + q4);
            u32x2 o; o.x = cvt_pk_bf16(w.x * rq[q4], w.y * rq[q4 + 1]); o.y = cvt_pk_bf16(w.z * rq[q4 + 2], w.w * rq[q4 + 3]);
            *(LAS u32x2*)(Wl + p * PITCH + q4) = o; }
#pragma unroll
        for (int k = 0; k < 4; ++k) { const int idx = k * 512 + F.tid, q = idx & 127, c8 = idx >> 7;
            const u32x4 v = *(const u32x4*)(GV + (size_t)(n * 128 + q) * D + g * 128 + c8 * 8);
            LAS bf16_t* t = Vt + (c8 * 8) * PITCH + q;
            t[0 * PITCH] = (bf16_t)(v.x & 0xffffu); t[1 * PITCH] = (bf16_t)(v.x >> 16); t[2 * PITCH] = (bf16_t)(v.y & 0xffffu); t[3 * PITCH] = (bf16_t)(v.y >> 16);
            t[4 * PITCH] = (bf16_t)(v.z & 0xffffu); t[5 * PITCH] = (bf16_t)(v.z >> 16); t[6 * PITCH] = (bf16_t)(v.w & 0xffffu); t[7 * PITCH] = (bf16_t)(v.w >> 16); }
        __syncthreads();
        f32x4 acc[2][4];
#pragma unroll
        for (int m = 0; m < 2; ++m)
#pragma unroll
            for (int nn = 0; nn < 4; ++nn) acc[m][nn] = (f32x4){0.f, 0.f, 0.f, 0.f};
#pragma unroll
        for (int kk = 0; kk < 4; ++kk) { bf16x8 af[2], bfr[4];
#pragma unroll
            for (int m = 0; m < 2; ++m) af[m] = *(const LAS bf16x8*)(Wl + (p0 + m * 16 + fr) * PITCH + kk * 32 + fq * 8);
#pragma unroll
            for (int nn = 0; nn < 4; ++nn) bfr[nn] = *(const LAS bf16x8*)(Vt + (c0 + nn * 16 + fr) * PITCH + kk * 32 + fq * 8);
#pragma unroll
            for (int m = 0; m < 2; ++m)
#pragma unroll
                for (int nn = 0; nn < 4; ++nn) acc[m][nn] = __builtin_amdgcn_mfma_f32_16x16x32_bf16(bfr[nn], af[m], acc[m][nn], 0, 0, 0); }
        const float* nv = a.in[I_NV] + l * D + g * 128; const float* bs = a.in[I_BS] + ((size_t)l * 8 + g) * 128;
#pragma unroll
        for (int m = 0; m < 2; ++m) { const int p = p0 + m * 16 + fr; const float bsp = bs[p];
#pragma unroll
            for (int nn = 0; nn < 4; ++nn) { const int c = c0 + nn * 16 + 4 * fq; const f32x4 nvv = *(const f32x4*)(nv + c);
                u32x2* up = (u32x2*)(UA + (size_t)(n * 128 + p) * D + g * 128 + c); const u32x2 uw = *up; const f32x4 v = acc[m][nn];
                u32x2 o; o.x = cvt_pk_bf16(bf_lo(uw.x) * (v[0] * nvv.x + bsp), bf_hi(uw.x) * (v[1] * nvv.y + bsp)); o.y = cvt_pk_bf16(bf_lo(uw.y) * (v[2] * nvv.z + bsp), bf_hi(uw.y) * (v[3] * nvv.w + bsp));
                *up = o; } }
        __syncthreads();
    }
}

__device__ __forceinline__ void scan_phase(const Frame& F, const Args& a, int l, const float* SB, bf16_t* UB) {
    LAS float* E = (LAS float*)F.lds;
    for (int it = F.vcu; it < 2 * NG * 2; it += F.G) {
        const int d = it & 1, g = (it >> 1) % NG, s = it / (2 * NG), p = F.lane, w = F.wave;
        const int ldg = (l * 2 + d) * NG + g;
        const int cfirst = d ? 255 - (w * 32 + 31) : w * 32;
        const GAS float* sp = (const GAS float*)(SB + ((size_t)g * NCH + s * 256 + cfirst) * 256 + d * 128 + p);
        float sr[32], si[32];
#pragma unroll
        for (int k = 0; k < 32; ++k) { sr[k] = sp[k * 256]; si[k] = sp[k * 256 + 64]; }
        const float lr = a.in[I_LRE][ldg * 64 + p], li = a.in[I_LIM][ldg * 64 + p], dt = expf(a.in[I_LDT][ldg]);
        const Cplx aL = apow(lr, li, dt, (float)SL), aS = apow(lr, li, dt, (float)(SL * 32));
        Cplx e{0.f, 0.f};
#pragma unroll
        for (int k = 0; k < 32; ++k) { const float xr = d ? sr[31 - k] : sr[k], xi = d ? si[31 - k] : si[k]; const Cplx t = cmul(aL, e); e.re = t.re + xr; e.im = t.im + xi; }
        E[(w * 64 + p) * 2] = e.re; E[(w * 64 + p) * 2 + 1] = e.im;
        __syncthreads();
        Cplx cy{0.f, 0.f};
        for (int j = 0; j < w; ++j) { const Cplx t = cmul(aS, cy); cy.re = t.re + E[(j * 64 + p) * 2]; cy.im = t.im + E[(j * 64 + p) * 2 + 1]; }
        GAS bf16_t* up = (GAS bf16_t*)(UB + ((size_t)g * NCH + s * 256 + cfirst) * KS5 + 512 + d * 128 + p);
        unsigned pw[32];
#pragma unroll
        for (int k = 0; k < 32; ++k) { const float xr = d ? sr[31 - k] : sr[k], xi = d ? si[31 - k] : si[k]; pw[k] = cvt_pk_bf16(cy.re, cy.im);
            const Cplx t = cmul(aL, cy); cy.re = t.re + xr; cy.im = t.im + xi; }
#pragma unroll
        for (int k = 0; k < 32; ++k) { const unsigned q = d ? pw[31 - k] : pw[k]; up[k * KS5] = (bf16_t)(q & 0xffffu); up[k * KS5 + 64] = (bf16_t)(q >> 16); }
        __syncthreads();
    }
}

#define XB_TMO      128
#define XB_XCNT(j)  (256  + 64 * (j))
#define XB_XSUB(j)  (1280 + 64 * (j))
#define XB_XGEN(j)  (2304 + 64 * (j))
#define XB_TOP      3328
#define XB_TOPGEN   3392
#define XCD_BAR_WORDS 3456
#define XB_SPIN_CAP (1u << 18)

__device__ __forceinline__ unsigned xb_ld(unsigned* p)              { return __hip_atomic_load(p, __ATOMIC_RELAXED, __HIP_MEMORY_SCOPE_AGENT); }
__device__ __forceinline__ unsigned xb_add(unsigned* p, unsigned v) { return __hip_atomic_fetch_add(p, v, __ATOMIC_RELAXED, __HIP_MEMORY_SCOPE_AGENT); }
__device__ __forceinline__ unsigned xb_xcc_id() { return (unsigned)__builtin_amdgcn_s_getreg((3 << 11) | 20) & 0xFu; }
#define XB_SPIN(cond, bar) do { unsigned _sp = 0; while (cond) { __builtin_amdgcn_s_sleep(1); \
    if ((++_sp & 255u) == 0u) { if (xb_ld(&(bar)[XB_TMO])) break; if (_sp > XB_SPIN_CAP) { atomicAdd(&(bar)[XB_TMO], 1u); break; } } } } while (0)

struct XcdBarrier {
    unsigned* bar; unsigned x;
    volatile LAS unsigned* st;
};

__device__ __forceinline__ XcdBarrier xcd_barrier_post(unsigned* bar, volatile LAS unsigned* st) {
    XcdBarrier b; b.bar = bar; b.x = xb_xcc_id(); b.st = st;
    if (threadIdx.x == 0) (void)xb_add(&bar[XB_XCNT(b.x)], 1u);
    return b;
}
__device__ __forceinline__ void xcd_barrier_complete(unsigned* bar, unsigned x, unsigned& nloc, unsigned& nx) {
    const unsigned G = gridDim.x * gridDim.y * gridDim.z;
    unsigned sum, cnt, mine, sp = 0u;
    for (;;) {
        sum = 0u; cnt = 0u; mine = 0u;
#pragma unroll
        for (unsigned j = 0; j < 16; ++j) { const unsigned c = xb_ld(&bar[XB_XCNT(j)]); sum += c; cnt += (c > 0u) ? 1u : 0u; mine = (j == x) ? c : mine; }
        if (sum == G) break;
        __builtin_amdgcn_s_sleep(1);
        if ((++sp & 255u) == 0u) { if (xb_ld(&bar[XB_TMO])) break; if (sp > XB_SPIN_CAP) { atomicAdd(&bar[XB_TMO], 1u); break; } }
    }
    nloc = mine > 0u ? mine : 1u; nx = cnt > 0u ? cnt : 1u;
}

__device__ __forceinline__ void xcd_barrier(const XcdBarrier& b) {
    asm volatile("s_waitcnt vmcnt(0)" ::: "memory");
    __syncthreads();
    if (threadIdx.x == 0) {
        unsigned* bar = b.bar;
        __builtin_amdgcn_s_waitcnt(0);
        unsigned nloc = b.st[0], nx = b.st[1];
        if (nloc == 0u) { xcd_barrier_complete(bar, b.x, nloc, nx); b.st[0] = nloc; b.st[1] = nx; }
        const unsigned old = xb_add(&bar[XB_XSUB(b.x)], 1u);
        const unsigned gen = old / nloc;
        if (old + 1u == (gen + 1u) * nloc) {
            __builtin_amdgcn_fence(__ATOMIC_RELEASE, "agent");
            asm volatile("s_waitcnt vmcnt(0)" ::: "memory");
            const unsigned og = xb_add(&bar[XB_TOP], 1u);
            const unsigned tg = og / nx;
            if (og + 1u == (tg + 1u) * nx) xb_add(&bar[XB_TOPGEN], 1u);
            else XB_SPIN(xb_ld(&bar[XB_TOPGEN]) == tg, bar);
            __builtin_amdgcn_fence(__ATOMIC_ACQUIRE, "agent");
            xb_add(&bar[XB_XGEN(b.x)], 1u);
            asm volatile("s_waitcnt vmcnt(0)" ::: "memory");
        } else {
            XB_SPIN(xb_ld(&bar[XB_XGEN(b.x)]) == gen, bar);
            __builtin_amdgcn_fence(__ATOMIC_ACQUIRE, "agent");
            asm volatile("s_waitcnt vmcnt(0)" ::: "memory");
        }
    }
    __syncthreads();
}


__device__ __forceinline__ void panel_group_barrier(unsigned* ctr, unsigned need = 4u) {
    asm volatile("s_waitcnt vmcnt(0) lgkmcnt(0)" ::: "memory");
    __syncthreads();
    if (threadIdx.x == 0) {
        __builtin_amdgcn_fence(__ATOMIC_RELEASE, "agent"); asm volatile("s_waitcnt vmcnt(0)" ::: "memory");
        (void)__hip_atomic_fetch_add(ctr, 1u, __ATOMIC_RELAXED, __HIP_MEMORY_SCOPE_AGENT);
        unsigned sp = 0; while (__hip_atomic_load(ctr, __ATOMIC_RELAXED, __HIP_MEMORY_SCOPE_AGENT) < need) { __builtin_amdgcn_s_sleep(1); if (++sp > (1u << 20)) break; }
        __builtin_amdgcn_fence(__ATOMIC_ACQUIRE, "agent"); asm volatile("s_waitcnt vmcnt(0)" ::: "memory");
    }
    __syncthreads();
}
constexpr int PH_PER = 12, NPH = 2 + NSLAB * DEPTH * PH_PER;

__global__ void __launch_bounds__(512, 2) mega_fwd(Args args) {
    extern __shared__ __attribute__((aligned(16))) unsigned char lds_raw[];
    cg::grid_group grid = cg::this_grid();
#define MKFRAME Frame F; { int t_ = threadIdx.x; asm volatile("" : "+v"(t_)); int bx = blockIdx.x; asm volatile("" : "+s"(bx)); int G_ = gridDim.x; asm volatile("" : "+s"(G_)); \
        F.lds = (LAS unsigned char*)lds_raw; F.tid = t_; F.lane = t_ & 63; F.wave = __builtin_amdgcn_readfirstlane(t_ >> 6); F.G = G_; F.vcu = (G_ % 8 == 0) ? (bx % 8) * (G_ / 8) + bx / 8 : bx; F.bx = bx; }
    const int lo = args.ph_lo, hi = args.ph_hi;
    volatile LAS unsigned* xst = (volatile LAS unsigned*)((LAS unsigned char*)lds_raw + 131072 + 64);
    if (threadIdx.x < 2) xst[threadIdx.x] = 0u;
    __syncthreads();
    XcdBarrier xbar = xcd_barrier_post((unsigned*)(args.ws + 4096), xst);
    if (hi < 0) grid.sync();
#ifndef SITE_MASK
#define SITE_MASK 0xffff
#endif
#define SITE(id) if constexpr (((SITE_MASK) >> ((id) >= 100 ? (id) - 100 + 13 : (id))) & 1)
    for (int ph = lo; ph < hi; ++ph) {
        const int pp = ph - 2, slab = pp / (DEPTH * PH_PER), l = (pp / PH_PER) % DEPTH, site = (ph < 2) ? 100 + ph : pp % PH_PER + 1;
#define P_XN ((bf16_t*)(args.ws + WS_XN))
#define P_UA ((bf16_t*)(args.ws + WS_UA))
#define P_GV ((bf16_t*)(args.ws + WS_GV))
#define P_UB ((bf16_t*)(args.ws + WS_UB))
#define P_GATE ((bf16_t*)(args.ws + WS_GATE))
#define P_Z ((bf16_t*)(args.ws + WS_Z))
#define P_SB ((float*)(args.ws + WS_SB))
#define P_SQ ((float*)(args.ws + WS_SQ))
#define P_HB ((bf16_t*)(args.ws + WS_H))
#define P_XOUT (args.out + (size_t)slab * TS * D)
#define P_WT (args.ws + WS_WT + (size_t)l * WT_LAYER)
#define P_S5 (args.ws + WS_S5 + (size_t)l * S5_LAYER)
        if (site == 3 || site == 7 || (gridDim.x == 256 && (site == 5 || site == 9 || site == 12))) continue;
        switch (site) {
        case 100: SITE(100) { MKFRAME; prologue_a(F, args); } break;
        case 101: SITE(101) { MKFRAME; prologue_b(F, args); } break;
        case 1: SITE(1) { MKFRAME;
            pg8::Gemm g{P_XN, (const bf16_t*)(P_WT + WT_IN), D, D, D, 0, 0}; pg8::StaticOrder S; S.init(TS, INW, F.G, F.bx);
            pg8::EpiIn E{P_UA, P_GV, P_UB, P_GATE, P_SQ}; pg8::gemm_phase(F.lds, g, S, E); } break;
        case 2: SITE(2) { MKFRAME;
            { pg8::Gemm g{P_UB, (const bf16_t*)(P_S5 + S5_WST), KS5, 512, 512, (size_t)NCH * KS5 * 2, (size_t)256 * 512 * 2}; pg8::BatchOrder S; S.init(NCH, 256, NG, F.G, F.vcu);
              pg8::EpiState E{P_SB}; pg8::gemm_phase(F.lds, g, S, E); }
            gating_phase(F, args, l, P_UA, P_GV, P_SQ); } break;
        case 4: SITE(4) { MKFRAME;
            scan_phase(F, args, l, P_SB, P_UB);
            if (F.G == 256) {
                const int it = F.vcu, d5 = it & 1, g5 = (it >> 1) % NG, s5i = it / (2 * NG);
                panel_group_barrier((unsigned*)(args.ws + WS_PCNT) + (size_t)(slab * DEPTH + l) * 128 * 64 + (it >> 1) * 64, 2u);
                pg8::Gemm g{P_UB, (const bf16_t*)(P_S5 + S5_TV), KS5, KS5, KS5, (size_t)NCH * KS5 * 2, (size_t)512 * KS5 * 2}; pg8::RangeOrder S{(g5 * 2 + s5i) * 2 + d5, 1, 4, 2};
                pg8::EpiS5 E{P_Z}; pg8::gemm_phase(F.lds, g, S, E); }
            { pg8::Gemm g{P_UA, (const bf16_t*)(P_WT + WT_OA), D, D, D, 0, 0}; pg8::StaticOrder S; S.init(TS, D, F.G, F.bx);
              pg8::EpiMixA E{P_GATE, P_GV}; pg8::gemm_phase(F.lds, g, S, E); } } break;
        case 5: SITE(5) { MKFRAME;
            pg8::Gemm g{P_UB, (const bf16_t*)(P_S5 + S5_TV), KS5, KS5, KS5, (size_t)NCH * KS5 * 2, (size_t)512 * KS5 * 2}; pg8::BatchOrder S; S.init(NCH, 512, NG, F.G, F.vcu);
            pg8::EpiS5 E{P_Z}; pg8::gemm_phase(F.lds, g, S, E); } break;
        case 6: SITE(6) { MKFRAME;
            pg8::Gemm g{P_Z, (const bf16_t*)(P_WT + WT_GLU), D, D, D, 0, 0}; pg8::StaticOrder S; S.init(TS, 2048, F.G, F.bx);
            pg8::EpiGlu E{P_GATE, P_GV, P_UA}; pg8::gemm_phase(F.lds, g, S, E); } break;
        case 8: SITE(8) { MKFRAME;
            pg8::Gemm g{P_UA, (const bf16_t*)(P_WT + WT_O), D, D, D, 0, 0}; pg8::StaticOrder S; S.init(TS, D, F.G, F.bx);
            if (F.G == 256) { const int itb = (slab * DEPTH + l) * 4;
                pg8::EpiRmsRes E{(l == 0) ? x_in_row(args, slab, 0) : nullptr, (l == 0) ? nullptr : (const bf16_t*)(args.ws + WS_XH), nullptr, (bf16_t*)(args.ws + WS_XH), args.in[I_NPOM] + l * D, args.in[I_NPF] + l * D, P_XN, (float*)(args.ws + WS_XB) + (size_t)itb * 64 * 256 * 4, (unsigned*)(args.ws + WS_CNT) + (size_t)itb * 64 * 64};
                pg8::gemm_phase(F.lds, g, S, E); }
            else { pg8::EpiSq E{P_XN, P_SQ}; pg8::gemm_phase(F.lds, g, S, E); } } break;
        case 9: SITE(9) { MKFRAME;
            if (F.G != 256) { const float* xin = (l == 0) ? x_in_row(args, slab, 0) : P_XOUT;
                resnorm(F, xin, P_XN, P_SQ, args.in[I_NPOM] + l * D, P_XOUT, args.in[I_NPF] + l * D, P_XN); } } break;
        case 10: SITE(10) { MKFRAME;
            pg8::Gemm g{P_XN, (const bf16_t*)(P_WT + WT_FF1), D, D, D, 0, 0}; pg8::StaticOrder S; S.init(TS, FF, F.G, F.bx);
            pg8::EpiRelu2 E{P_HB}; pg8::gemm_phase(F.lds, g, S, E); } break;
        case 11: SITE(11) { MKFRAME;
            pg8::Gemm g{P_HB, (const bf16_t*)(P_WT + WT_FF2), FF, FF, FF, 0, 0}; pg8::StaticOrder S; S.init(TS, D, F.G, F.bx);
            if (F.G == 256) { const int itb = (slab * DEPTH + l) * 4 + 2;
                pg8::EpiRmsRes E{nullptr, (const bf16_t*)(args.ws + WS_XH), (l + 1 < DEPTH) ? nullptr : P_XOUT, (l + 1 < DEPTH) ? (bf16_t*)(args.ws + WS_XH) : nullptr, args.in[I_NPOF] + l * D, (l + 1 < DEPTH) ? args.in[I_NPM] + (l + 1) * D : nullptr, P_XN, (float*)(args.ws + WS_XB) + (size_t)itb * 64 * 256 * 4, (unsigned*)(args.ws + WS_CNT) + (size_t)itb * 64 * 64};
                pg8::gemm_phase(F.lds, g, S, E);
                if (l + 1 == DEPTH && slab + 1 < NSLAB) enorm0(F, args, slab + 1, P_XN); }
            else { pg8::EpiSq E{P_Z, P_SQ}; pg8::gemm_phase(F.lds, g, S, E); } } break;
        default: SITE(12) { MKFRAME;
            if (F.G != 256) resnorm(F, P_XOUT, P_Z, P_SQ, args.in[I_NPOF] + l * D, P_XOUT, (l + 1 < DEPTH) ? args.in[I_NPM] + (l + 1) * D : nullptr, P_XN);
            if (l + 1 == DEPTH && slab + 1 < NSLAB) enorm0(F, args, slab + 1, P_XN); } break;
        }
        if (ph + 1 < hi) {
            if (gridDim.x == 256 && (site == 6 || site == 10)) {
                const int c = blockIdx.x, pmg = (c % 8) * 8 + (c / 8) % 8, bank = (slab * DEPTH + l) * 2 + (site == 10 ? 1 : 0);
                panel_group_barrier((unsigned*)(args.ws + WS_GCNT) + (size_t)bank * 64 * 64 + pmg * 64);
            } else xcd_barrier(xbar);
        }
    }
#undef SITE
}


extern "C" void kernel_launch(void* const* d_in, const int* in_sizes, int n_in, void* d_out, int out_size, void* d_ws, size_t ws_size, hipStream_t stream) {
    static int grid = 0;
    if (grid == 0) {
        if (n_in != 23 || out_size != NSLAB * TS * D || ws_size < WS_END) { fprintf(stderr, "kernel_launch: unexpected shapes (n_in %d out %d ws %zu)\n", n_in, out_size, ws_size); grid = -1; return; }
        int dev = 0, cus = 0, per_cu = 0;
        hipGetDevice(&dev); hipDeviceGetAttribute(&cus, hipDeviceAttributeMultiprocessorCount, dev);
        if (hipFuncSetAttribute((const void*)mega_fwd, hipFuncAttributeMaxDynamicSharedMemorySize, LDS_BYTES) != hipSuccess) { fprintf(stderr, "kernel_launch: hipFuncSetAttribute failed\n"); grid = -1; return; }
        if (hipOccupancyMaxActiveBlocksPerMultiprocessor(&per_cu, (const void*)mega_fwd, 512, LDS_BYTES) != hipSuccess || per_cu < 1) { fprintf(stderr, "kernel_launch: occupancy query says %d\n", per_cu); per_cu = 1; }
        (void)hipGetLastError();
        grid = cus;
        if (grid % 8 != 0 || grid <= 0) grid = 256;
    }
    if (grid < 0) return;
    Args a{};
    for (int i = 0; i < 23; ++i) a.in[i] = (const float*)d_in[i];
    a.out = (float*)d_out; a.ws = (unsigned char*)d_ws;
#if MK_MULTI
    for (int p = 0; p < NPH; ++p) { a.ph_lo = p; a.ph_hi = p + 1; hipLaunchKernelGGL(mega_fwd, dim3(grid), dim3(512), LDS_BYTES, stream, a);
    }
#else
    a.ph_lo = 0; a.ph_hi = NPH;
    (void)hipMemsetAsync(d_ws, 0, CTL_ZERO, stream);
    void* kargs[] = {&a};
    hipError_t e = hipLaunchCooperativeKernel((const void*)mega_fwd, dim3(grid), dim3(512), kargs, LDS_BYTES, stream);
    if (e != hipSuccess) fprintf(stderr, "kernel_launch: cooperative launch failed: %s (grid %d)\n", hipGetErrorString(e), grid);
#endif
}
```

```cpp
#include <hip/hip_runtime.h>
#include <hip/hip_cooperative_groups.h>
#include <cstdio>
#include <cstdint>
namespace cg = cooperative_groups;

#ifndef MK_MULTI
#define MK_MULTI 0
#endif

#define LAS __attribute__((address_space(3)))
#define GAS __attribute__((address_space(1)))
typedef unsigned short bf16_t;
typedef short bf16x8 __attribute__((ext_vector_type(8)));
typedef float f32x4 __attribute__((ext_vector_type(4)));
typedef float f32x2 __attribute__((ext_vector_type(2)));
typedef unsigned u32x4 __attribute__((ext_vector_type(4)));
typedef unsigned u32x2 __attribute__((ext_vector_type(2)));

constexpr int D = 1024, FF = 4096, INW = 5120, DEPTH = 2;
constexpr int TS = 16384;
constexpr int NSLAB = 3;
constexpr int SEQ = 8192;
constexpr int SL = 32;
constexpr int NCH = TS / SL;
constexpr int KS5 = 768;
constexpr int NG = 64;
constexpr float EPS = 1e-6f;

constexpr size_t MiB = 1u << 20;
constexpr size_t WS_WT = 1 * MiB;
constexpr size_t WT_IN = 0, WT_OA = 10 * MiB, WT_GLU = 12 * MiB, WT_O = 16 * MiB, WT_FF1 = 18 * MiB, WT_FF2 = 26 * MiB, WT_LAYER = 34 * MiB;
constexpr size_t WS_S5 = 69 * MiB;
constexpr size_t S5_WST = 0, S5_TV = 16 * MiB, S5_LAYER = 64 * MiB;
constexpr size_t WS_KTAB = 197 * MiB;
constexpr size_t WS_XN = 205 * MiB;
constexpr size_t WS_UA = 237 * MiB;
constexpr size_t WS_GV = 269 * MiB;
constexpr size_t WS_UB = 301 * MiB;
constexpr size_t WS_GATE = 349 * MiB;
constexpr size_t WS_Z = 413 * MiB;
constexpr size_t WS_SB = 445 * MiB;
constexpr size_t WS_SQ = 203 * MiB;
constexpr size_t WS_XH = 478 * MiB;
constexpr size_t WS_H = 237 * MiB;
constexpr size_t WS_XB = 197 * MiB;
constexpr size_t WS_CNT = 128 * 1024;
constexpr size_t WS_GCNT = 512 * 1024;
constexpr size_t CTL_ZERO = 768 * 1024;
constexpr size_t WS_END = 512 * MiB;

constexpr int LDS_BYTES = 139264;

typedef __bf16 bf16x2_t __attribute__((ext_vector_type(2)));
__device__ __forceinline__ unsigned cvt_pk_bf16(float lo, float hi) { const f32x2 v = {lo, hi}; const bf16x2_t b = __builtin_convertvector(v, bf16x2_t); return __builtin_bit_cast(unsigned, b); }
__device__ __forceinline__ float bf_lo(unsigned w) { return __builtin_bit_cast(float, w << 16); }
__device__ __forceinline__ float bf_hi(unsigned w) { return __builtin_bit_cast(float, w & 0xffff0000u); }
__device__ __forceinline__ float gelu_t(float v) { const float u = v * (1.0f + 0.044715f * v * v) * -2.302208198f; return v * __builtin_amdgcn_rcpf(1.0f + __builtin_amdgcn_exp2f(u)); }
__device__ __forceinline__ float sigm(float v) { return __builtin_amdgcn_rcpf(1.0f + __builtin_amdgcn_exp2f(-1.4426950409f * v)); }
__device__ __forceinline__ unsigned pack4_u8(const f32x4 v) { unsigned w = 0; w = __builtin_amdgcn_cvt_pk_u8_f32(v[0] * 255.f, 0, w); w = __builtin_amdgcn_cvt_pk_u8_f32(v[1] * 255.f, 1, w); w = __builtin_amdgcn_cvt_pk_u8_f32(v[2] * 255.f, 2, w); w = __builtin_amdgcn_cvt_pk_u8_f32(v[3] * 255.f, 3, w); return w; }
__device__ __forceinline__ f32x4 unpack4_u8(unsigned w) { return (f32x4){(float)(w & 255u), (float)((w >> 8) & 255u), (float)((w >> 16) & 255u), (float)(w >> 24)} * (1.f / 255.f); }
__device__ __forceinline__ float wave_sum(float v) {
#pragma unroll
    for (int o = 1; o < 64; o <<= 1) v += __shfl_xor(v, o);
    return v;
}

namespace pg8 {
constexpr int BM = 256, BK = 64, HALF = 128, HTB = HALF * BK * 2, STAGE_BYTES = 8 * HTB, NXCD = 8, WGM = 8;
__device__ __forceinline__ int lds_byte(int r, int c) { const int st = (r >> 4) * 2 + (c >> 5), rr = r & 15, cc = c & 31, ob = rr * 64 + cc * 2; return st * 1024 + (ob ^ (((ob >> 9) & 1) << 5)); }
__device__ __forceinline__ void stage_rc(int b, int& R, int& C) { const int st = b / 1024, sb = b % 1024, swz = sb ^ (((sb >> 9) & 1) << 5); R = (st >> 1) * 16 + swz / 64; C = (st & 1) * 32 + (swz % 64) / 2; }
__device__ __forceinline__ int perm32(int rho) { const int n = rho >> 4, i = rho & 15; return 8 * (i >> 2) + 4 * n + (i & 3); }

struct Unit { int pm, pn, pb; };
struct Gemm { const bf16_t* A; const bf16_t* Bt; int lda, ldb, K; size_t sA, sB; };

struct StaticOrder {
    int nM, nN, nwg, G, c;
    __device__ void init(int M, int N, int G_, int c_) { nM = M / BM; nN = N / BM; nwg = nM * nN; G = G_; c = c_; }
    __device__ bool next(int i, Unit& u) const {
        const long L = (long)i * G + c; if (L >= nwg) return false;
        int wgid = (int)L; { const int q = nwg / NXCD, r = nwg % NXCD, xcd = wgid % NXCD, off = wgid / NXCD; wgid = (xcd < r ? xcd * (q + 1) : r * (q + 1) + (xcd - r) * q) + off; }
        const int nig = WGM * nN, gid = wgid / nig, fm = gid * WGM, gsz = (nM - fm) < WGM ? (nM - fm) : WGM;
        u.pm = fm + ((wgid % nig) % gsz); u.pn = (wgid % nig) / gsz; u.pb = 0; return true;
    }
};
struct BatchOrder {
    int nM, nN, nB, G, c;
    __device__ void init(int M, int N, int B, int G_, int c_) { nM = M / BM; nN = N / BM; nB = B; G = G_; c = c_; }
    __device__ bool next(int i, Unit& u) const {
        const int L = i * G + c; const int per = nM * nN; if (L >= nB * per) return false;
        u.pb = L / per; const int r = L % per; u.pm = r / nN; u.pn = r % nN; return true;
    }
};

template <class Epi, class Sched>
__device__ __forceinline__ void gemm_phase(LAS unsigned char* lds, const Gemm g, const Sched& S, const Epi& E, u32x4* dummy = nullptr) {
    int tid_ = threadIdx.x; asm volatile("" : "+v"(tid_));
    const int tid = tid_, wid = __builtin_amdgcn_readfirstlane(tid >> 6), lane = tid & 63, wr = wid >> 2, wc = wid & 3, fr = lane & 15, fq = lane >> 4;
    const int K = g.K, nt = K / BK;
    unsigned voffA[2], voffB[2];
#pragma unroll
    for (int i = 0; i < 2; ++i) { int R, C; stage_rc(tid * 16 + i * 8192, R, C); const int Rb = Epi::PERM ? ((R & ~31) + perm32(R & 31)) : R;
        voffA[i] = (unsigned)(R * g.lda + C) * 2u; voffB[i] = (unsigned)(Rb * g.ldb + C) * 2u; }
    const size_t kstep = (size_t)(BK * 2);
    const size_t hA = (size_t)HALF * g.lda * 2, hB = (size_t)HALF * g.ldb * 2;
    const size_t tA = 2 * hA, tB = 2 * hB;
    const unsigned ldsw = (unsigned)wid * 1024u;
    const int aoff = lds_byte(wr * 64 + fr, fq * 8), boff = lds_byte(wc * 32 + fr, fq * 8);
#define PG8_SA(b, h) (((b) * 2 + (h)) * HTB)
#define PG8_SB(b, h) ((4 + (b) * 2 + (h)) * HTB)
#define PG8_STAGE(bufoff, gbase, voff) do { _Pragma("unroll") for (int _i = 0; _i < 2; ++_i) \
        __builtin_amdgcn_global_load_lds((const unsigned*)((const char*)(gbase) + (voff)[_i]), (LAS unsigned*)(lds + (bufoff) + ldsw + _i * 8192), 16, 0, 0); } while (0)
#define PG8_LDA(dst, b, h) do { _Pragma("unroll") for (int m = 0; m < 4; ++m) _Pragma("unroll") for (int k = 0; k < 2; ++k) dst[m][k] = *(const LAS bf16x8*)(lds + PG8_SA(b, h) + aoff + m * 2048 + k * 1024); } while (0)
#define PG8_LDB(dst, b, h) do { _Pragma("unroll") for (int n = 0; n < 2; ++n) _Pragma("unroll") for (int k = 0; k < 2; ++k) dst[n][k] = *(const LAS bf16x8*)(lds + PG8_SB(b, h) + boff + n * 2048 + k * 1024); } while (0)
#define PG8_MMA(ai, bj, At, Bt) do { __builtin_amdgcn_s_setprio(1); _Pragma("unroll") for (int m = 0; m < 4; ++m) _Pragma("unroll") for (int n = 0; n < 2; ++n) _Pragma("unroll") for (int k = 0; k < 2; ++k) \
        acc[ai][bj][m][n] = __builtin_amdgcn_mfma_f32_16x16x32_bf16(Bt[n][k], At[m][k], acc[ai][bj][m][n], 0, 0, 0); __builtin_amdgcn_s_setprio(0); } while (0)
#define PG8_WAIT_V(n) asm volatile("s_waitcnt vmcnt(" #n ")" ::: "memory")
#define PG8_WAIT_VN(N) asm volatile("s_waitcnt vmcnt(%0)" :: "n"(N) : "memory")
#define PG8_WAIT_L(n) asm volatile("s_waitcnt lgkmcnt(" #n ")" ::: "memory")
#define PG8_BAR __builtin_amdgcn_s_barrier()
#define PG8_SCHED __builtin_amdgcn_sched_barrier(0)
    Unit cur, nxt; int ui = 0;
    if (!S.next(0, cur)) return;
    f32x4 acc[2][2][4][2];
#pragma unroll
    for (int a = 0; a < 2; ++a)
#pragma unroll
        for (int b = 0; b < 2; ++b)
#pragma unroll
            for (int m = 0; m < 4; ++m)
#pragma unroll
                for (int n = 0; n < 2; ++n) acc[a][b][m][n] = (f32x4){0.f, 0.f, 0.f, 0.f};
    bf16x8 At[4][2], B0[2][2], B1[2][2];
    const char* cA = (const char*)g.A + (size_t)cur.pb * g.sA + (size_t)cur.pm * tA; const char* cB = (const char*)g.Bt + (size_t)cur.pb * g.sB + (size_t)cur.pn * tB;
    PG8_STAGE(PG8_SB(0, 0), cB, voffB); PG8_STAGE(PG8_SB(0, 1), cB + hB, voffB); PG8_STAGE(PG8_SA(0, 0), cA, voffA); PG8_STAGE(PG8_SA(0, 1), cA + hA, voffA);
    if (wr == 1) PG8_BAR;
    PG8_WAIT_V(2); PG8_BAR;
    PG8_STAGE(PG8_SB(1, 0), cB + kstep, voffB); PG8_STAGE(PG8_SA(1, 0), cA + kstep, voffA); PG8_STAGE(PG8_SB(1, 1), cB + hB + kstep, voffB);
    PG8_WAIT_V(6); PG8_BAR;
    if constexpr (Epi::NST > 0) {
        PG8_STAGE(PG8_SA(1, 1), cA + kstep + hA, voffA);
        _Pragma("unroll") for (int q = 0; q < Epi::NST; ++q) { asm volatile("" ::: "memory"); dummy[tid] = (u32x4){0u, 0u, 0u, 0u}; }
        asm volatile("" ::: "memory");
    }
    for (;;) {
        const bool has_next = S.next(ui + 1, nxt);
        const char* nA = has_next ? (const char*)g.A + (size_t)nxt.pb * g.sA + (size_t)nxt.pm * tA : cA;
        const char* nB = has_next ? (const char*)g.Bt + (size_t)nxt.pb * g.sB + (size_t)nxt.pn * tB : cB;
#define PG8_KPAIR(ST11, W1, W2, W3, W4) \
            PG8_LDB(B0, 0, 0); PG8_LDB(B1, 0, 1); PG8_SCHED; PG8_LDA(At, 0, 0); ST11; \
            PG8_WAIT_VN(W1); PG8_WAIT_L(0); PG8_BAR; PG8_MMA(0, 0, At, B0); PG8_MMA(0, 1, At, B1); PG8_BAR; PG8_SCHED; \
            PG8_LDA(At, 0, 1); PG8_STAGE(PG8_SB(0, 0), b2, voffB); PG8_STAGE(PG8_SB(0, 1), b2 + hB, voffB); PG8_STAGE(PG8_SA(0, 0), a2, voffA); \
            PG8_WAIT_VN(W2); PG8_WAIT_L(0); PG8_BAR; PG8_MMA(1, 0, At, B0); PG8_MMA(1, 1, At, B1); PG8_BAR; PG8_SCHED; \
            PG8_LDB(B0, 1, 0); PG8_LDB(B1, 1, 1); PG8_SCHED; PG8_LDA(At, 1, 0); PG8_STAGE(PG8_SA(0, 1), a2 + hA, voffA); \
            PG8_WAIT_VN(W3); PG8_WAIT_L(0); PG8_BAR; PG8_MMA(0, 0, At, B0); PG8_MMA(0, 1, At, B1); PG8_BAR; PG8_SCHED; \
            PG8_LDA(At, 1, 1); PG8_STAGE(PG8_SB(1, 0), b3, voffB); PG8_STAGE(PG8_SB(1, 1), b3 + hB, voffB); PG8_STAGE(PG8_SA(1, 0), a3, voffA); \
            PG8_WAIT_VN(W4); PG8_WAIT_L(0); PG8_BAR; PG8_MMA(1, 0, At, B0); PG8_MMA(1, 1, At, B1); PG8_BAR; PG8_SCHED;
        int t0 = 0;
        if constexpr (Epi::NST > 0) {
            const char* a2 = cA + (size_t)2 * kstep; const char* b2 = cB + (size_t)2 * kstep; const char* a3 = a2 + kstep; const char* b3 = b2 + kstep;
            PG8_KPAIR((void)0, 8 + Epi::NST, 8 + Epi::NST, 8 + Epi::NST, 8)
            t0 = 2;
        }
        for (int t = t0; t < nt; t += 2) {
            const bool last = (t == nt - 2);
            const char* a1 = cA + (size_t)(t + 1) * kstep;
            const char* a2 = last ? nA : cA + (size_t)(t + 2) * kstep; const char* b2 = last ? nB : cB + (size_t)(t + 2) * kstep;
            const char* a3 = a2 + kstep; const char* b3 = b2 + kstep;
            PG8_KPAIR(PG8_STAGE(PG8_SA(1, 1), a1 + hA, voffA), 8, 8, 8, 8)
        }
        if (wr == 0) PG8_BAR;
        if constexpr (Epi::NST > 0) { if (has_next) PG8_STAGE(PG8_SA(1, 1), nA + kstep + hA, voffA); }
        if constexpr (!Epi::AFTER_DRAIN) { int t2 = threadIdx.x; asm volatile("" : "+v"(t2));
            E(acc, cur, wr, wc, t2 & 15, (t2 & 63) >> 4); }
        if (!has_next) break;
#pragma unroll
        for (int a = 0; a < 2; ++a)
#pragma unroll
            for (int b = 0; b < 2; ++b)
#pragma unroll
                for (int m = 0; m < 4; ++m)
#pragma unroll
                    for (int n = 0; n < 2; ++n) acc[a][b][m][n] = (f32x4){0.f, 0.f, 0.f, 0.f};
        cur = nxt; cA = nA; cB = nB; ++ui;
        if (wr == 1) PG8_BAR;
    }
    PG8_WAIT_V(0);
    PG8_BAR;
    if constexpr (Epi::AFTER_DRAIN) E.fused(acc, cur, wr, wc, fr, fq, lds, wid, lane);
#undef PG8_SA
#undef PG8_SB
#undef PG8_STAGE
#undef PG8_LDA
#undef PG8_LDB
#undef PG8_MMA
#undef PG8_WAIT_V
#undef PG8_WAIT_VN
#undef PG8_KPAIR
#undef PG8_WAIT_L
#undef PG8_BAR
#undef PG8_SCHED
}

typedef f32x4 Acc[2][2][4][2];
__device__ __forceinline__ u32x4 pack8(const f32x4 a, const f32x4 b) { u32x4 w; w.x = cvt_pk_bf16(a[0], a[1]); w.y = cvt_pk_bf16(a[2], a[3]); w.z = cvt_pk_bf16(b[0], b[1]); w.w = cvt_pk_bf16(b[2], b[3]); return w; }

struct EpiIn {
    static constexpr bool PERM = true, AFTER_DRAIN = false; static constexpr int NST = 0;
    bf16_t *UA, *GV, *UB, *GATE; float* VSQ;
    __device__ __forceinline__ void operator()(const Acc& acc, const Unit& u, int wr, int wc, int fr, int fq) const {
        const int pn = u.pn, row0 = u.pm * 256 + wr * 64 + fr, cl = wc * 32 + 8 * fq;
        if (pn < 8) {
            bf16_t* O = (pn < 4) ? UA : GV; const int cb = (pn & 3) * 256 + cl;
#pragma unroll
            for (int ai = 0; ai < 2; ++ai)
#pragma unroll
                for (int m = 0; m < 4; ++m) { const int row = row0 + ai * 128 + m * 16; float ss = 0.f;
#pragma unroll
                    for (int bj = 0; bj < 2; ++bj) { f32x4 v0 = acc[ai][bj][m][0], v1 = acc[ai][bj][m][1];
#pragma unroll
                        for (int j = 0; j < 4; ++j) { v0[j] = gelu_t(v0[j]); v1[j] = gelu_t(v1[j]); ss += v0[j] * v0[j] + v1[j] * v1[j]; }
                        *(u32x4*)(O + (size_t)row * D + cb + bj * 128) = pack8(v0, v1); }
                    if (pn >= 4) { ss += __shfl_xor(ss, 16); ss += __shfl_xor(ss, 32); if (fq == 0) VSQ[row * 16 + (pn - 4) * 4 + wc] = ss; } }
        } else if (pn < 12) {
#pragma unroll
            for (int ai = 0; ai < 2; ++ai)
#pragma unroll
                for (int m = 0; m < 4; ++m) { const int row = row0 + ai * 128 + m * 16, chunk = row >> 5, j = row & 31;
#pragma unroll
                    for (int bj = 0; bj < 2; ++bj) { const int cb = (pn - 8) * 256 + bj * 128 + cl, g = cb >> 4, h0 = cb & 15;
                        *(u32x4*)(UB + ((size_t)(g * NCH + chunk) * KS5 + j * 16 + h0)) = pack8(acc[ai][bj][m][0], acc[ai][bj][m][1]); } }
        } else {
            const int cb = (pn - 12) * 256 + cl;
#pragma unroll
            for (int ai = 0; ai < 2; ++ai)
#pragma unroll
                for (int m = 0; m < 4; ++m) { const int row = row0 + ai * 128 + m * 16;
#pragma unroll
                    for (int bj = 0; bj < 2; ++bj) { f32x4 v0 = acc[ai][bj][m][0], v1 = acc[ai][bj][m][1];
#pragma unroll
                        for (int j = 0; j < 4; ++j) { v0[j] = sigm(v0[j]); v1[j] = sigm(v1[j]); }
                        u32x2 o; o.x = pack4_u8(v0); o.y = pack4_u8(v1); *(u32x2*)((unsigned char*)GATE + (size_t)row * 2048 + cb + bj * 128) = o; } }
        }
    }
};
struct EpiState {
    static constexpr bool PERM = false, AFTER_DRAIN = false; static constexpr int NST = 0;
    float* SB;
    __device__ __forceinline__ void operator()(const Acc& acc, const Unit& u, int wr, int wc, int fr, int fq) const {
        GAS float* rp = (GAS float*)(SB + ((size_t)u.pb * NCH + u.pm * 256 + wr * 64 + fr) * 256 + wc * 32 + 4 * fq);
#pragma unroll
        for (int ai = 0; ai < 2; ++ai) {
#pragma unroll
            for (int m = 0; m < 4; ++m) {
                asm volatile("" : "+v"(rp));
#pragma unroll
                for (int bj = 0; bj < 2; ++bj)
#pragma unroll
                    for (int n = 0; n < 2; ++n) *(GAS f32x4*)(rp + bj * 128 + n * 16) = acc[ai][bj][m][n];
                rp += 16 * 256; }
            rp += 64 * 256; }
    }
};
struct EpiS5 {
    static constexpr bool PERM = true, AFTER_DRAIN = false; static constexpr int NST = 0;
    bf16_t* Z;
    __device__ __forceinline__ void operator()(const Acc& acc, const Unit& u, int wr, int wc, int fr, int fq) const {
        const int row0 = u.pm * 256 + wr * 64 + fr, cl = u.pn * 256 + wc * 32 + 8 * fq;
#pragma unroll
        for (int ai = 0; ai < 2; ++ai)
#pragma unroll
            for (int m = 0; m < 4; ++m) { const int chunk = row0 + ai * 128 + m * 16;
#pragma unroll
                for (int bj = 0; bj < 2; ++bj) { const int n = cl + bj * 128, i = n >> 4, h0 = n & 15; f32x4 v0 = acc[ai][bj][m][0], v1 = acc[ai][bj][m][1];
#pragma unroll
                    for (int j = 0; j < 4; ++j) { v0[j] = gelu_t(v0[j]); v1[j] = gelu_t(v1[j]); }
                    *(u32x4*)(Z + (size_t)(chunk * SL + i) * D + u.pb * 16 + h0) = pack8(v0, v1); } }
    }
};
struct EpiGlu {
    static constexpr bool PERM = true, AFTER_DRAIN = false; static constexpr int NST = 0;
    const bf16_t* GATE; const bf16_t* MA; bf16_t* MI;
    __device__ __forceinline__ void operator()(const Acc& acc, const Unit& u, int wr, int wc, int fr, int fq) const {
        const int row0 = u.pm * 256 + wr * 64 + fr, j0 = u.pn * 128 + wc * 32 + 8 * fq;
#pragma unroll
        for (int ai = 0; ai < 2; ++ai)
#pragma unroll
            for (int m = 0; m < 4; ++m) { const int row = row0 + ai * 128 + m * 16;
                const u32x2 g8 = *(const u32x2*)((const unsigned char*)GATE + (size_t)row * 2048 + 1024 + j0); const f32x4 ga = unpack4_u8(g8.x), gb = unpack4_u8(g8.y); const u32x4 mw = *(const u32x4*)(MA + (size_t)row * D + j0);
                f32x4 a0 = acc[ai][0][m][0], a1 = acc[ai][0][m][1]; const f32x4 b0 = acc[ai][1][m][0], b1 = acc[ai][1][m][1];
                a0[0] = a0[0] * sigm(b0[0]) * ga[0] + bf_lo(mw.x); a0[1] = a0[1] * sigm(b0[1]) * ga[1] + bf_hi(mw.x); a0[2] = a0[2] * sigm(b0[2]) * ga[2] + bf_lo(mw.y); a0[3] = a0[3] * sigm(b0[3]) * ga[3] + bf_hi(mw.y);
                a1[0] = a1[0] * sigm(b1[0]) * gb[0] + bf_lo(mw.z); a1[1] = a1[1] * sigm(b1[1]) * gb[1] + bf_hi(mw.z); a1[2] = a1[2] * sigm(b1[2]) * gb[2] + bf_lo(mw.w); a1[3] = a1[3] * sigm(b1[3]) * gb[3] + bf_hi(mw.w);
                *(u32x4*)(MI + (size_t)row * D + j0) = pack8(a0, a1); }
    }
};
struct EpiMixA {
    static constexpr bool PERM = true, AFTER_DRAIN = false; static constexpr int NST = 0;
    const bf16_t* GATE; bf16_t* MA;
    __device__ __forceinline__ void operator()(const Acc& acc, const Unit& u, int wr, int wc, int fr, int fq) const {
        const int row0 = u.pm * 256 + wr * 64 + fr, cl = u.pn * 256 + wc * 32 + 8 * fq;
#pragma unroll
        for (int ai = 0; ai < 2; ++ai)
#pragma unroll
            for (int m = 0; m < 4; ++m) { const int row = row0 + ai * 128 + m * 16;
#pragma unroll
                for (int bj = 0; bj < 2; ++bj) { const int c = cl + bj * 128; f32x4 v0 = acc[ai][bj][m][0], v1 = acc[ai][bj][m][1];
                    const u32x2 g8 = *(const u32x2*)((const unsigned char*)GATE + (size_t)row * 2048 + c);
                    v0 = v0 * unpack4_u8(g8.x); v1 = v1 * unpack4_u8(g8.y);
                    *(u32x4*)(MA + (size_t)row * D + c) = pack8(v0, v1); } }
    }
};
struct EpiSq {
    static constexpr bool PERM = true, AFTER_DRAIN = false; static constexpr int NST = 0;
    bf16_t* O; float* SQ;
    __device__ __forceinline__ void operator()(const Acc& acc, const Unit& u, int wr, int wc, int fr, int fq) const {
        const int row0 = u.pm * 256 + wr * 64 + fr, cl = u.pn * 256 + wc * 32 + 8 * fq;
#pragma unroll
        for (int ai = 0; ai < 2; ++ai)
#pragma unroll
            for (int m = 0; m < 4; ++m) { const int row = row0 + ai * 128 + m * 16; float ss = 0.f;
#pragma unroll
                for (int bj = 0; bj < 2; ++bj) { const f32x4 v0 = acc[ai][bj][m][0], v1 = acc[ai][bj][m][1];
#pragma unroll
                    for (int j = 0; j < 4; ++j) ss += v0[j] * v0[j] + v1[j] * v1[j];
                    *(u32x4*)(O + (size_t)row * D + cl + bj * 128) = pack8(v0, v1); }
                ss += __shfl_xor(ss, 16); ss += __shfl_xor(ss, 32); if (fq == 0) SQ[row * 16 + u.pn * 4 + wc] = ss; }
    }
};
struct EpiRelu2 {
    static constexpr bool PERM = true, AFTER_DRAIN = false; static constexpr int NST = 16;
    bf16_t* H;
    __device__ __forceinline__ void operator()(const Acc& acc, const Unit& u, int wr, int wc, int fr, int fq) const {
        const int row0 = u.pm * 256 + wr * 64 + fr, cl = u.pn * 256 + wc * 32 + 8 * fq;
#pragma unroll
        for (int ai = 0; ai < 2; ++ai)
#pragma unroll
            for (int m = 0; m < 4; ++m) { const int row = row0 + ai * 128 + m * 16;
#pragma unroll
                for (int bj = 0; bj < 2; ++bj) { f32x4 v0 = acc[ai][bj][m][0], v1 = acc[ai][bj][m][1];
#pragma unroll
                    for (int j = 0; j < 4; ++j) { const float a = fmaxf(v0[j], 0.f), b = fmaxf(v1[j], 0.f); v0[j] = a * a; v1[j] = b * b; }
                    *(u32x4*)(H + (size_t)row * FF + cl + bj * 128) = pack8(v0, v1); } }
    }
};

struct EpiRmsRes {
    static constexpr bool PERM = true, AFTER_DRAIN = true; static constexpr int NST = 0;
    const float* xin32; const bf16_t* xin16; float* xout32; bf16_t* xout16; const float* gpost; const float* gnext; bf16_t* XN; float* xbuf; unsigned* cnt;
    __device__ __forceinline__ void stats(const float (&ss)[2][4], float (&rs)[2][4], const Unit& u, int wr, int wc, int fr, int fq, LAS unsigned char* lds, int wid, int lane, int bank) const {
        LAS float* P = (LAS float*)lds; LAS float* S = P + 1024; const int tid = wid * 64 + lane;
#pragma unroll
        for (int ai = 0; ai < 2; ++ai)
#pragma unroll
            for (int m = 0; m < 4; ++m) { float v = ss[ai][m]; v += __shfl_xor(v, 16); v += __shfl_xor(v, 32); if (fq == 0) P[(ai * 128 + wr * 64 + m * 16 + fr) * 4 + wc] = v; }
        __syncthreads();
        float* xb = xbuf + (size_t)bank * 64 * 256 * 4 + (size_t)u.pm * 256 * 4; unsigned* c = cnt + (size_t)bank * 64 * 64 + u.pm * 64;
        if (tid < 256) { const float v = (P[tid * 4 + 0] + P[tid * 4 + 1]) + (P[tid * 4 + 2] + P[tid * 4 + 3]); __hip_atomic_store(xb + tid * 4 + u.pn, v, __ATOMIC_RELAXED, __HIP_MEMORY_SCOPE_AGENT); }
        asm volatile("s_waitcnt vmcnt(0)" ::: "memory");
        if (wid < 4 && lane == 0) __hip_atomic_fetch_add(c, 1u, __ATOMIC_RELAXED, __HIP_MEMORY_SCOPE_AGENT);
        if (wid == 0) { unsigned sp = 0; while (__hip_atomic_load(c, __ATOMIC_RELAXED, __HIP_MEMORY_SCOPE_AGENT) < 16u) { __builtin_amdgcn_s_sleep(1); if (++sp > (1u << 20)) break; }
            __builtin_amdgcn_fence(__ATOMIC_ACQUIRE, "agent"); asm volatile("s_waitcnt vmcnt(0)" ::: "memory"); }
        __syncthreads();
        if (tid < 256) { const float t = (__hip_atomic_load(xb + tid * 4 + 0, __ATOMIC_RELAXED, __HIP_MEMORY_SCOPE_AGENT) + __hip_atomic_load(xb + tid * 4 + 1, __ATOMIC_RELAXED, __HIP_MEMORY_SCOPE_AGENT))
                                     + (__hip_atomic_load(xb + tid * 4 + 2, __ATOMIC_RELAXED, __HIP_MEMORY_SCOPE_AGENT) + __hip_atomic_load(xb + tid * 4 + 3, __ATOMIC_RELAXED, __HIP_MEMORY_SCOPE_AGENT));
            S[tid] = rsqrtf(t * (1.f / D) + EPS); }
        __syncthreads();
#pragma unroll
        for (int ai = 0; ai < 2; ++ai)
#pragma unroll
            for (int m = 0; m < 4; ++m) rs[ai][m] = S[ai * 128 + wr * 64 + m * 16 + fr];
        __syncthreads();
    }
    __device__ __forceinline__ void fused(Acc& acc, const Unit& u, int wr, int wc, int fr, int fq, LAS unsigned char* lds, int wid, int lane) const {
        float ss[2][4], rs[2][4];
#pragma unroll
        for (int ai = 0; ai < 2; ++ai)
#pragma unroll
            for (int m = 0; m < 4; ++m) { float q = 0.f;
#pragma unroll
                for (int bj = 0; bj < 2; ++bj)
#pragma unroll
                    for (int n = 0; n < 2; ++n) { const f32x4 v = acc[ai][bj][m][n]; q += (v[0] * v[0] + v[1] * v[1]) + (v[2] * v[2] + v[3] * v[3]); }
                ss[ai][m] = q; }
        stats(ss, rs, u, wr, wc, fr, fq, lds, wid, lane, 0);
        const int row0 = u.pm * 256 + wr * 64 + fr, col0 = u.pn * 256 + wc * 32 + 8 * fq;
#pragma unroll
        for (int ai = 0; ai < 2; ++ai)
#pragma unroll
            for (int m = 0; m < 4; ++m) { const size_t ro = (size_t)(row0 + ai * 128 + m * 16) * D + col0; float q = 0.f;
#pragma unroll
                for (int bj = 0; bj < 2; ++bj) { const int co = bj * 128; f32x4 x0, x1;
                    if (xin32) { x0 = *(const f32x4*)(xin32 + ro + co); x1 = *(const f32x4*)(xin32 + ro + co + 4); }
                    else { const u32x4 w = *(const u32x4*)(xin16 + ro + co); x0 = (f32x4){bf_lo(w.x), bf_hi(w.x), bf_lo(w.y), bf_hi(w.y)}; x1 = (f32x4){bf_lo(w.z), bf_hi(w.z), bf_lo(w.w), bf_hi(w.w)}; }
                    const f32x4 g0 = *(const f32x4*)(gpost + col0 + co), g1 = *(const f32x4*)(gpost + col0 + co + 4);
                    const f32x4 v0 = x0 + acc[ai][bj][m][0] * rs[ai][m] * g0, v1 = x1 + acc[ai][bj][m][1] * rs[ai][m] * g1; acc[ai][bj][m][0] = v0; acc[ai][bj][m][1] = v1;
                    if (xout32) { *(f32x4*)(xout32 + ro + co) = v0; *(f32x4*)(xout32 + ro + co + 4) = v1; } else *(u32x4*)(xout16 + ro + co) = pack8(v0, v1);
                    q += ((v0[0] * v0[0] + v0[1] * v0[1]) + (v0[2] * v0[2] + v0[3] * v0[3])) + ((v1[0] * v1[0] + v1[1] * v1[1]) + (v1[2] * v1[2] + v1[3] * v1[3])); }
                ss[ai][m] = q; }
        if (gnext) {
            stats(ss, rs, u, wr, wc, fr, fq, lds, wid, lane, 1);
#pragma unroll
            for (int ai = 0; ai < 2; ++ai)
#pragma unroll
                for (int m = 0; m < 4; ++m) { const size_t ro = (size_t)(row0 + ai * 128 + m * 16) * D + col0;
#pragma unroll
                    for (int bj = 0; bj < 2; ++bj) { const int co = bj * 128; const f32x4 g0 = *(const f32x4*)(gnext + col0 + co), g1 = *(const f32x4*)(gnext + col0 + co + 4);
                        *(u32x4*)(XN + ro + co) = pack8(acc[ai][bj][m][0] * rs[ai][m] * g0, acc[ai][bj][m][1] * rs[ai][m] * g1); } }
        }
    }
};
}

struct Args { const float* in[23]; float* out; unsigned char* ws; int ph_lo, ph_hi; };
enum { I_XP = 0, I_XS, I_NPM, I_WIN, I_NV, I_WS, I_BS, I_WOA, I_LRE, I_LIM, I_LDT, I_BRE, I_BIM, I_CRE, I_CIM, I_DSK, I_WGLU, I_WO, I_NPOM, I_NPF, I_WFF1, I_WFF2, I_NPOF };

struct Frame { LAS unsigned char* lds; int tid, lane, wave, vcu, G, bx; };

__device__ __forceinline__ void transpose_item(const float* W, int K, int N, bf16_t* WT, bool glu, LAS float* scr, int item, int lane) {
    const int nblk = N / 32, kb = item / nblk, nb = item % nblk, k0 = 64 * kb, n0 = 32 * nb;
#pragma unroll 8
    for (int i = 0; i < 32; ++i) { const int kk = 2 * i + (lane >> 5); scr[kk * 33 + (lane & 31)] = W[(size_t)(k0 + kk) * N + n0 + (lane & 31)]; }
    asm volatile("s_waitcnt lgkmcnt(0)" ::: "memory");
    const int c = lane & 7;
#pragma unroll
    for (int j = 0; j < 4; ++j) { const int n = (lane >> 3) + 8 * j; const LAS float* s = scr + (8 * c) * 33 + n;
        u32x4 o; o.x = cvt_pk_bf16(s[0 * 33], s[1 * 33]); o.y = cvt_pk_bf16(s[2 * 33], s[3 * 33]); o.z = cvt_pk_bf16(s[4 * 33], s[5 * 33]); o.w = cvt_pk_bf16(s[6 * 33], s[7 * 33]);
        int nn = n0 + n; if (glu) { const int sj = nn >> 10, j = nn & 1023; nn = (j >> 7) * 256 + sj * 128 + (j & 127); }
        *(u32x4*)(WT + (size_t)nn * K + k0 + 8 * c) = o; }
    asm volatile("s_waitcnt lgkmcnt(0)" ::: "memory");
}

__device__ __forceinline__ const float* x_in_row(const Args& a, int slab, int r) {
    return (slab == 0 ? a.in[I_XP] : a.in[I_XS] + (size_t)(slab - 1) * TS * D) + (size_t)r * D;
}
__device__ __forceinline__ void enorm0(const Frame& F, const Args& a, int slab, bf16_t* XN) {
    const int gw = F.vcu * 8 + F.wave, NGW = F.G * 8; const float* g = a.in[I_NPM];
    for (int r = gw; r < TS; r += NGW) {
        const f32x4* xr = (const f32x4*)x_in_row(a, slab, r) + F.lane; f32x4 v[4]; float s = 0.f;
#pragma unroll
        for (int j = 0; j < 4; ++j) { v[j] = xr[64 * j]; s += (v[j].x * v[j].x + v[j].y * v[j].y) + (v[j].z * v[j].z + v[j].w * v[j].w); }
        const float rs = rsqrtf(wave_sum(s) * (1.f / D) + EPS);
        u32x2* o = (u32x2*)(XN + (size_t)r * D) + F.lane;
#pragma unroll
        for (int j = 0; j < 4; ++j) { const f32x4 gg = ((const f32x4*)g)[F.lane + 64 * j]; u32x2 w; w.x = cvt_pk_bf16(v[j].x * rs * gg.x, v[j].y * rs * gg.y); w.y = cvt_pk_bf16(v[j].z * rs * gg.z, v[j].w * rs * gg.w); o[64 * j] = w; }
    }
}
__device__ __forceinline__ void resnorm(const Frame& F, const float* xin, const bf16_t* Y, const float* SQ, const float* gpost, float* xout, const float* gnext, bf16_t* XN) {
    const int gw = F.vcu * 8 + F.wave, NGW = F.G * 8;
    for (int r = gw; r < TS; r += NGW) {
        const f32x4 q0 = ((const f32x4*)(SQ + r * 16))[0], q1 = ((const f32x4*)(SQ + r * 16))[1], q2 = ((const f32x4*)(SQ + r * 16))[2], q3 = ((const f32x4*)(SQ + r * 16))[3];
        const float ssq = ((q0.x + q0.y) + (q0.z + q0.w)) + ((q1.x + q1.y) + (q1.z + q1.w)) + ((q2.x + q2.y) + (q2.z + q2.w)) + ((q3.x + q3.y) + (q3.z + q3.w));
        const float ry = rsqrtf(ssq * (1.f / D) + EPS);
        const f32x4* xr = (const f32x4*)(xin + (size_t)r * D) + F.lane; const u32x2* yr = (const u32x2*)(Y + (size_t)r * D) + F.lane;
        f32x4 v[4]; float s = 0.f;
#pragma unroll
        for (int j = 0; j < 4; ++j) { const f32x4 x = xr[64 * j]; const u32x2 y = yr[64 * j]; const f32x4 gg = ((const f32x4*)gpost)[F.lane + 64 * j];
            v[j].x = x.x + bf_lo(y.x) * ry * gg.x; v[j].y = x.y + bf_hi(y.x) * ry * gg.y; v[j].z = x.z + bf_lo(y.y) * ry * gg.z; v[j].w = x.w + bf_hi(y.y) * ry * gg.w;
            s += (v[j].x * v[j].x + v[j].y * v[j].y) + (v[j].z * v[j].z + v[j].w * v[j].w); }
        f32x4* xo = (f32x4*)(xout + (size_t)r * D) + F.lane;
#pragma unroll
        for (int j = 0; j < 4; ++j) xo[64 * j] = v[j];
        if (gnext) { const float rs = rsqrtf(wave_sum(s) * (1.f / D) + EPS); u32x2* o = (u32x2*)(XN + (size_t)r * D) + F.lane;
#pragma unroll
            for (int j = 0; j < 4; ++j) { const f32x4 gg = ((const f32x4*)gnext)[F.lane + 64 * j]; u32x2 w; w.x = cvt_pk_bf16(v[j].x * rs * gg.x, v[j].y * rs * gg.y); w.y = cvt_pk_bf16(v[j].z * rs * gg.z, v[j].w * rs * gg.w); o[64 * j] = w; } }
    }
}

struct Cplx { float re, im; };
__device__ __forceinline__ Cplx cmul(Cplx a, Cplx b) { return Cplx{a.re * b.re - a.im * b.im, a.re * b.im + a.im * b.re}; }
__device__ __forceinline__ Cplx apow(float lr, float li, float dt, float e) { const float m = expf(lr * dt * e); float sn, cs; sincosf(li * dt * e, &sn, &cs); return Cplx{m * cs, m * sn}; }
__device__ __forceinline__ Cplx zoh_coef(float lr, float li, float dt) { const Cplx a = apow(lr, li, dt, 1.f); const float xr = a.re - 1.f, xi = a.im, den = 1.f / (lr * lr + li * li); return Cplx{(xr * lr + xi * li) * den, (xi * lr - xr * li) * den}; }

__device__ __forceinline__ void prologue_a(const Frame& F, const Args& a) {
    LAS float* scr = (LAS float*)(F.lds + F.wave * 16384);
    const int gw = F.vcu * 8 + F.wave, NGW = F.G * 8;
    constexpr int I_IN = (D / 64) * (INW / 32), I_SQ = (D / 64) * (D / 32), I_GLU = (D / 64) * (2048 / 32), I_F1 = (D / 64) * (FF / 32), I_F2 = (FF / 64) * (D / 32);
    constexpr int PER_L = I_IN + 2 * I_SQ + I_GLU + I_F1 + I_F2;
    for (int it = gw; it < DEPTH * PER_L; it += NGW) {
        const int l = it / PER_L; int r = it % PER_L; unsigned char* wt = a.ws + WS_WT + (size_t)l * WT_LAYER;
        if (r < I_IN) { transpose_item(a.in[I_WIN] + (size_t)l * D * INW, D, INW, (bf16_t*)(wt + WT_IN), false, scr, r, F.lane); continue; } r -= I_IN;
        if (r < I_SQ) { transpose_item(a.in[I_WOA] + (size_t)l * D * D, D, D, (bf16_t*)(wt + WT_OA), false, scr, r, F.lane); continue; } r -= I_SQ;
        if (r < I_GLU) { transpose_item(a.in[I_WGLU] + (size_t)l * D * 2048, D, 2048, (bf16_t*)(wt + WT_GLU), true, scr, r, F.lane); continue; } r -= I_GLU;
        if (r < I_SQ) { transpose_item(a.in[I_WO] + (size_t)l * D * D, D, D, (bf16_t*)(wt + WT_O), false, scr, r, F.lane); continue; } r -= I_SQ;
        if (r < I_F1) { transpose_item(a.in[I_WFF1] + (size_t)l * D * FF, D, FF, (bf16_t*)(wt + WT_FF1), false, scr, r, F.lane); continue; } r -= I_F1;
        transpose_item(a.in[I_WFF2] + (size_t)l * FF * D, FF, D, (bf16_t*)(wt + WT_FF2), false, scr, r, F.lane);
    }
    float* KT = (float*)(a.ws + WS_KTAB);
    for (int it = gw; it < DEPTH * NG * 2 * SL; it += NGW) {
        const int tau = it % SL, d = (it / SL) % 2, g = (it / (2 * SL)) % NG, l = it / (2 * SL * NG);
        const int ldg = (l * 2 + d) * NG + g, p = F.lane;
        const float lr = a.in[I_LRE][ldg * 64 + p], li = a.in[I_LIM][ldg * 64 + p], dt = expf(a.in[I_LDT][ldg]);
        const Cplx w = cmul(apow(lr, li, dt, (float)tau), zoh_coef(lr, li, dt));
        const int ho = F.lane >> 2, hi0 = (F.lane & 3) * 4;
        f32x4 o = {0.f, 0.f, 0.f, 0.f};
#pragma unroll 8
        for (int pp = 0; pp < 64; ++pp) {
            const float wr_ = __shfl(w.re, pp), wi_ = __shfl(w.im, pp);
            const float cr = a.in[I_CRE][((size_t)ldg * 16 + ho) * 64 + pp], ci = a.in[I_CIM][((size_t)ldg * 16 + ho) * 64 + pp];
            const f32x4 br = *(const f32x4*)(a.in[I_BRE] + ((size_t)ldg * 64 + pp) * 16 + hi0), bi = *(const f32x4*)(a.in[I_BIM] + ((size_t)ldg * 64 + pp) * 16 + hi0);
            const float xr = cr * wr_ - ci * wi_, xi = cr * wi_ + ci * wr_;
            o.x += xr * br.x - xi * bi.x; o.y += xr * br.y - xi * bi.y; o.z += xr * br.z - xi * bi.z; o.w += xr * br.w - xi * bi.w;
        }
        *(f32x4*)(KT + (size_t)it * 256 + ho * 16 + hi0) = o;
    }
    enorm0(F, a, 0, (bf16_t*)(a.ws + WS_XN));
}
__device__ __forceinline__ void prologue_b(const Frame& F, const Args& a) {
    const int gt = (F.vcu * 8 + F.wave) * 64 + F.lane, NGT = F.G * 512;
    const float* KT = (const float*)(a.ws + WS_KTAB);
    for (int it = gt; it < DEPTH * NG * 2 * 64 * SL; it += NGT) {
        const int j = it % SL, p = (it / SL) % 64, d = (it / (SL * 64)) % 2, g = (it / (SL * 128)) % NG, l = it / (SL * 128 * NG);
        const int ldg = (l * 2 + d) * NG + g;
        const float lr = a.in[I_LRE][ldg * 64 + p], li = a.in[I_LIM][ldg * 64 + p], dt = expf(a.in[I_LDT][ldg]);
        const Cplx z = cmul(apow(lr, li, dt, d == 0 ? (float)(SL - 1 - j) : (float)j), zoh_coef(lr, li, dt));
        bf16_t* W = (bf16_t*)(a.ws + WS_S5 + (size_t)l * S5_LAYER + S5_WST) + ((size_t)g * 256 + d * 128 + p) * 512 + j * 16;
        const float* br = a.in[I_BRE] + ((size_t)ldg * 64 + p) * 16; const float* bi = a.in[I_BIM] + ((size_t)ldg * 64 + p) * 16;
#pragma unroll
        for (int h8 = 0; h8 < 2; ++h8) { float re[8], im[8];
#pragma unroll
            for (int k = 0; k < 8; ++k) { const float b_r = br[h8 * 8 + k], b_i = bi[h8 * 8 + k]; re[k] = z.re * b_r - z.im * b_i; im[k] = z.re * b_i + z.im * b_r; }
            u32x4 o; o.x = cvt_pk_bf16(re[0], re[1]); o.y = cvt_pk_bf16(re[2], re[3]); o.z = cvt_pk_bf16(re[4], re[5]); o.w = cvt_pk_bf16(re[6], re[7]);
            *(u32x4*)(W + h8 * 8) = o;
            o.x = cvt_pk_bf16(im[0], im[1]); o.y = cvt_pk_bf16(im[2], im[3]); o.z = cvt_pk_bf16(im[4], im[5]); o.w = cvt_pk_bf16(im[6], im[7]);
            *(u32x4*)(W + (size_t)64 * 512 + h8 * 8) = o; }
    }
    for (int it = gt; it < DEPTH * NG * 2 * SL * 64; it += NGT) {
        const int p = it % 64, i = (it / 64) % SL, d = (it / (64 * SL)) % 2, g = (it / (128 * SL)) % NG, l = it / (128 * SL * NG);
        const int ldg = (l * 2 + d) * NG + g;
        const float lr = a.in[I_LRE][ldg * 64 + p], li = a.in[I_LIM][ldg * 64 + p], dt = expf(a.in[I_LDT][ldg]);
        const Cplx z = apow(lr, li, dt, d == 0 ? (float)(i + 1) : (float)(SL - i));
        bf16_t* T = (bf16_t*)(a.ws + WS_S5 + (size_t)l * S5_LAYER + S5_TV) + ((size_t)g * 512 + i * 16) * KS5 + 512 + d * 128 + p;
#pragma unroll 4
        for (int ho = 0; ho < 16; ++ho) { const float cr = a.in[I_CRE][((size_t)ldg * 16 + ho) * 64 + p], ci = a.in[I_CIM][((size_t)ldg * 16 + ho) * 64 + p];
            const unsigned w = cvt_pk_bf16(cr * z.re - ci * z.im, -(cr * z.im + ci * z.re));
            T[(size_t)ho * KS5] = (bf16_t)(w & 0xffffu); T[(size_t)ho * KS5 + 64] = (bf16_t)(w >> 16); }
    }
    for (int it = gt; it < DEPTH * NG * 512 * 64; it += NGT) {
        const int kb = it % 64, n = (it / 64) % 512, g = (it / (64 * 512)) % NG, l = it / (64 * 512 * NG);
        const int j = kb >> 1, hi0 = (kb & 1) * 8, i = n >> 4, ho = n & 15;
        f32x4 v0 = {0.f, 0.f, 0.f, 0.f}, v1 = v0;
        if (j <= i) { const float* k = KT + ((((size_t)(l * NG + g) * 2 + 0) * SL + (i - j)) * 16 + ho) * 16 + hi0; v0 += *(const f32x4*)k; v1 += *(const f32x4*)(k + 4); }
        if (j >= i) { const float* k = KT + ((((size_t)(l * NG + g) * 2 + 1) * SL + (j - i)) * 16 + ho) * 16 + hi0; v0 += *(const f32x4*)k; v1 += *(const f32x4*)(k + 4); }
        if (j == i && (ho >> 3) == (kb & 1)) { const float dk = a.in[I_DSK][l * D + g * 16 + ho]; const int e = ho & 7;
            if (e < 4) v0[e] += dk; else v1[e - 4] += dk; }
        *(u32x4*)((bf16_t*)(a.ws + WS_S5 + (size_t)l * S5_LAYER + S5_TV) + ((size_t)g * 512 + n) * KS5 + j * 16 + hi0) = pg8::pack8(v0, v1);
    }
}

__device__ __forceinline__ void gating_phase(const Frame& F, const Args& a, int l, bf16_t* UA, const bf16_t* GV, const float* VSQ) {
    constexpr int PITCH = 136;
    LAS bf16_t* Wl = (LAS bf16_t*)F.lds; LAS bf16_t* Vt = Wl + 128 * PITCH; LAS float* rq = (LAS float*)(Vt + 128 * PITCH);
    const int fr = F.lane & 15, fq = F.lane >> 4, p0 = (F.wave >> 1) * 32, c0 = (F.wave & 1) * 64;
    const bool bal = (F.G == 256); const int it0 = bal ? (F.vcu < 128 ? F.vcu * 3 : 384 + (F.vcu - 128) * 5) : F.vcu, itn = bal ? (F.vcu < 128 ? 3 : 5) : ((TS / 128) * 8 - F.vcu + F.G - 1) / F.G, its = bal ? 1 : F.G;
    for (int ii = 0; ii < itn; ++ii) { const int it = it0 + ii * its;
        const int n = it >> 3, g = it & 7;
        if (F.tid < 128) { const float* q = VSQ + (size_t)(n * 128 + F.tid) * 16; float s = 0.f;
#pragma unroll
            for (int k = 0; k < 16; ++k) s += q[k];
            rq[F.tid] = rsqrtf(s * (1.f / D) + EPS); }
        __syncthreads();
        const float* Ws = a.in[I_WS] + ((size_t)l * 8 + g) * 128 * 128;
#pragma unroll
        for (int k = 0; k < 8; ++k) { const int idx = k * 512 + F.tid, p = idx >> 5, q4 = (idx & 31) * 4; const f32x4 w = *(const f32x4*)(Ws + p * 128 + q4);
            u32x2 o; o.x = cvt_pk_bf16(w.x * rq[q4], w.y * rq[q4 + 1]); o.y = cvt_pk_bf16(w.z * rq[q4 + 2], w.w * rq[q4 + 3]);
            *(LAS u32x2*)(Wl + p * PITCH + q4) = o; }
#pragma unroll
        for (int k = 0; k < 4; ++k) { const int idx = k * 512 + F.tid, q = idx & 127, c8 = idx >> 7;
            const u32x4 v = *(const u32x4*)(GV + (size_t)(n * 128 + q) * D + g * 128 + c8 * 8);
            LAS bf16_t* t = Vt + (c8 * 8) * PITCH + q;
            t[0 * PITCH] = (bf16_t)(v.x & 0xffffu); t[1 * PITCH] = (bf16_t)(v.x >> 16); t[2 * PITCH] = (bf16_t)(v.y & 0xffffu); t[3 * PITCH] = (bf16_t)(v.y >> 16);
            t[4 * PITCH] = (bf16_t)(v.z & 0xffffu); t[5 * PITCH] = (bf16_t)(v.z >> 16); t[6 * PITCH] = (bf16_t)(v.w & 0xffffu); t[7 * PITCH] = (bf16_t)(v.w >> 16); }
        __syncthreads();
        f32x4 acc[2][4];
#pragma unroll
        for (int m = 0; m < 2; ++m)
#pragma unroll
            for (int nn = 0; nn < 4; ++nn) acc[m][nn] = (f32x4){0.f, 0.f, 0.f, 0.f};
#pragma unroll
        for (int kk = 0; kk < 4; ++kk) { bf16x8 af[2], bfr[4];
#pragma unroll
            for (int m = 0; m < 2; ++m) af[m] = *(const LAS bf16x8*)(Wl + (p0 + m * 16 + fr) * PITCH + kk * 32 + fq * 8);
#pragma unroll
            for (int nn = 0; nn < 4; ++nn) bfr[nn] = *(const LAS bf16x8*)(Vt + (c0 + nn * 16 + fr) * PITCH + kk * 32 + fq * 8);
#pragma unroll
            for (int m = 0; m < 2; ++m)
#pragma unroll
                for (int nn = 0; nn < 4; ++nn) acc[m][nn] = __builtin_amdgcn_mfma_f32_16x16x32_bf16(bfr[nn], af[m], acc[m][nn], 0, 0, 0); }
        const float* nv = a.in[I_NV] + l * D + g * 128; const float* bs = a.in[I_BS] + ((size_t)l * 8 + g) * 128;
#pragma unroll
        for (int m = 0; m < 2; ++m) { const int p = p0 + m * 16 + fr; const float bsp = bs[p];
#pragma unroll
            for (int nn = 0; nn < 4; ++nn) { const int c = c0 + nn * 16 + 4 * fq; const f32x4 nvv = *(const f32x4*)(nv + c);
                u32x2* up = (u32x2*)(UA + (size_t)(n * 128 + p) * D + g * 128 + c); const u32x2 uw = *up; const f32x4 v = acc[m][nn];
                u32x2 o; o.x = cvt_pk_bf16(bf_lo(uw.x) * (v[0] * nvv.x + bsp), bf_hi(uw.x) * (v[1] * nvv.y + bsp)); o.y = cvt_pk_bf16(bf_lo(uw.y) * (v[2] * nvv.z + bsp), bf_hi(uw.y) * (v[3] * nvv.w + bsp));
                *up = o; } }
        __syncthreads();
    }
}

__device__ __forceinline__ void scan_phase(const Frame& F, const Args& a, int l, const float* SB, bf16_t* UB) {
    LAS float* E = (LAS float*)F.lds;
    for (int it = F.vcu; it < 2 * NG * 2; it += F.G) {
        const int d = it & 1, g = (it >> 1) % NG, s = it / (2 * NG), p = F.lane, w = F.wave;
        const int ldg = (l * 2 + d) * NG + g;
        const int cfirst = d ? 255 - (w * 32 + 31) : w * 32;
        const GAS float* sp = (const GAS float*)(SB + ((size_t)g * NCH + s * 256 + cfirst) * 256 + d * 128 + p);
        float sr[32], si[32];
#pragma unroll
        for (int k = 0; k < 32; ++k) { sr[k] = sp[k * 256]; si[k] = sp[k * 256 + 64]; }
        const float lr = a.in[I_LRE][ldg * 64 + p], li = a.in[I_LIM][ldg * 64 + p], dt = expf(a.in[I_LDT][ldg]);
        const Cplx aL = apow(lr, li, dt, (float)SL), aS = apow(lr, li, dt, (float)(SL * 32));
        Cplx e{0.f, 0.f};
#pragma unroll
        for (int k = 0; k < 32; ++k) { const float xr = d ? sr[31 - k] : sr[k], xi = d ? si[31 - k] : si[k]; const Cplx t = cmul(aL, e); e.re = t.re + xr; e.im = t.im + xi; }
        E[(w * 64 + p) * 2] = e.re; E[(w * 64 + p) * 2 + 1] = e.im;
        __syncthreads();
        Cplx cy{0.f, 0.f};
        for (int j = 0; j < w; ++j) { const Cplx t = cmul(aS, cy); cy.re = t.re + E[(j * 64 + p) * 2]; cy.im = t.im + E[(j * 64 + p) * 2 + 1]; }
        GAS bf16_t* up = (GAS bf16_t*)(UB + ((size_t)g * NCH + s * 256 + cfirst) * KS5 + 512 + d * 128 + p);
        unsigned pw[32];
#pragma unroll
        for (int k = 0; k < 32; ++k) { const float xr = d ? sr[31 - k] : sr[k], xi = d ? si[31 - k] : si[k]; pw[k] = cvt_pk_bf16(cy.re, cy.im);
            const Cplx t = cmul(aL, cy); cy.re = t.re + xr; cy.im = t.im + xi; }
#pragma unroll
        for (int k = 0; k < 32; ++k) { const unsigned q = d ? pw[31 - k] : pw[k]; up[k * KS5] = (bf16_t)(q & 0xffffu); up[k * KS5 + 64] = (bf16_t)(q >> 16); }
        __syncthreads();
    }
}

#define XB_TMO      128
#define XB_XCNT(j)  (256  + 64 * (j))
#define XB_XSUB(j)  (1280 + 64 * (j))
#define XB_XGEN(j)  (2304 + 64 * (j))
#define XB_TOP      3328
#define XB_TOPGEN   3392
#define XCD_BAR_WORDS 3456
#define XB_SPIN_CAP (1u << 18)

__device__ __forceinline__ unsigned xb_ld(unsigned* p)              { return __hip_atomic_load(p, __ATOMIC_RELAXED, __HIP_MEMORY_SCOPE_AGENT); }
__device__ __forceinline__ unsigned xb_add(unsigned* p, unsigned v) { return __hip_atomic_fetch_add(p, v, __ATOMIC_RELAXED, __HIP_MEMORY_SCOPE_AGENT); }
__device__ __forceinline__ unsigned xb_xcc_id() { return (unsigned)__builtin_amdgcn_s_getreg((3 << 11) | 20) & 0xFu; }
#define XB_SPIN(cond, bar) do { unsigned _sp = 0; while (cond) { __builtin_amdgcn_s_sleep(1); \
    if ((++_sp & 255u) == 0u) { if (xb_ld(&(bar)[XB_TMO])) break; if (_sp > XB_SPIN_CAP) { atomicAdd(&(bar)[XB_TMO], 1u); break; } } } } while (0)

struct XcdBarrier {
    unsigned* bar; unsigned x;
    volatile LAS unsigned* st;
};

__device__ __forceinline__ XcdBarrier xcd_barrier_post(unsigned* bar, volatile LAS unsigned* st) {
    XcdBarrier b; b.bar = bar; b.x = xb_xcc_id(); b.st = st;
    if (threadIdx.x == 0) (void)xb_add(&bar[XB_XCNT(b.x)], 1u);
    return b;
}
__device__ __forceinline__ void xcd_barrier_complete(unsigned* bar, unsigned x, unsigned& nloc, unsigned& nx) {
    const unsigned G = gridDim.x * gridDim.y * gridDim.z;
    unsigned sum, cnt, mine, sp = 0u;
    for (;;) {
        sum = 0u; cnt = 0u; mine = 0u;
#pragma unroll
        for (unsigned j = 0; j < 16; ++j) { const unsigned c = xb_ld(&bar[XB_XCNT(j)]); sum += c; cnt += (c > 0u) ? 1u : 0u; mine = (j == x) ? c : mine; }
        if (sum == G) break;
        __builtin_amdgcn_s_sleep(1);
        if ((++sp & 255u) == 0u) { if (xb_ld(&bar[XB_TMO])) break; if (sp > XB_SPIN_CAP) { atomicAdd(&bar[XB_TMO], 1u); break; } }
    }
    nloc = mine > 0u ? mine : 1u; nx = cnt > 0u ? cnt : 1u;
}

__device__ __forceinline__ void xcd_barrier(const XcdBarrier& b) {
    asm volatile("s_waitcnt vmcnt(0)" ::: "memory");
    __syncthreads();
    if (threadIdx.x == 0) {
        unsigned* bar = b.bar;
        __builtin_amdgcn_s_waitcnt(0);
        unsigned nloc = b.st[0], nx = b.st[1];
        if (nloc == 0u) { xcd_barrier_complete(bar, b.x, nloc, nx); b.st[0] = nloc; b.st[1] = nx; }
        const unsigned old = xb_add(&bar[XB_XSUB(b.x)], 1u);
        const unsigned gen = old / nloc;
        if (old + 1u == (gen + 1u) * nloc) {
            __builtin_amdgcn_fence(__ATOMIC_RELEASE, "agent");
            asm volatile("s_waitcnt vmcnt(0)" ::: "memory");
            const unsigned og = xb_add(&bar[XB_TOP], 1u);
            const unsigned tg = og / nx;
            if (og + 1u == (tg + 1u) * nx) xb_add(&bar[XB_TOPGEN], 1u);
            else XB_SPIN(xb_ld(&bar[XB_TOPGEN]) == tg, bar);
            __builtin_amdgcn_fence(__ATOMIC_ACQUIRE, "agent");
            xb_add(&bar[XB_XGEN(b.x)], 1u);
            asm volatile("s_waitcnt vmcnt(0)" ::: "memory");
        } else {
            XB_SPIN(xb_ld(&bar[XB_XGEN(b.x)]) == gen, bar);
            __builtin_amdgcn_fence(__ATOMIC_ACQUIRE, "agent");
            asm volatile("s_waitcnt vmcnt(0)" ::: "memory");
        }
    }
    __syncthreads();
}


__device__ __forceinline__ void panel_group_barrier(unsigned* ctr) {
    asm volatile("s_waitcnt vmcnt(0) lgkmcnt(0)" ::: "memory");
    __syncthreads();
    if (threadIdx.x == 0) {
        __builtin_amdgcn_fence(__ATOMIC_RELEASE, "agent"); asm volatile("s_waitcnt vmcnt(0)" ::: "memory");
        (void)__hip_atomic_fetch_add(ctr, 1u, __ATOMIC_RELAXED, __HIP_MEMORY_SCOPE_AGENT);
        unsigned sp = 0; while (__hip_atomic_load(ctr, __ATOMIC_RELAXED, __HIP_MEMORY_SCOPE_AGENT) < 4u) { __builtin_amdgcn_s_sleep(1); if (++sp > (1u << 20)) break; }
        __builtin_amdgcn_fence(__ATOMIC_ACQUIRE, "agent"); asm volatile("s_waitcnt vmcnt(0)" ::: "memory");
    }
    __syncthreads();
}
constexpr int PH_PER = 12, NPH = 2 + NSLAB * DEPTH * PH_PER;

__global__ void __launch_bounds__(512, 2) mega_fwd(Args args) {
    extern __shared__ __attribute__((aligned(16))) unsigned char lds_raw[];
    cg::grid_group grid = cg::this_grid();
#define MKFRAME Frame F; { int t_ = threadIdx.x; asm volatile("" : "+v"(t_)); int bx = blockIdx.x; asm volatile("" : "+s"(bx)); int G_ = gridDim.x; asm volatile("" : "+s"(G_)); \
        F.lds = (LAS unsigned char*)lds_raw; F.tid = t_; F.lane = t_ & 63; F.wave = __builtin_amdgcn_readfirstlane(t_ >> 6); F.G = G_; F.vcu = (G_ % 8 == 0) ? (bx % 8) * (G_ / 8) + bx / 8 : bx; F.bx = bx; }
    const int lo = args.ph_lo, hi = args.ph_hi;
    volatile LAS unsigned* xst = (volatile LAS unsigned*)((LAS unsigned char*)lds_raw + 131072 + 64);
    if (threadIdx.x < 2) xst[threadIdx.x] = 0u;
    __syncthreads();
    XcdBarrier xbar = xcd_barrier_post((unsigned*)(args.ws + 4096), xst);
    if (hi < 0) grid.sync();
#ifndef SITE_MASK
#define SITE_MASK 0xffff
#endif
#define SITE(id) if constexpr (((SITE_MASK) >> ((id) >= 100 ? (id) - 100 + 13 : (id))) & 1)
    for (int ph = lo; ph < hi; ++ph) {
        const int pp = ph - 2, slab = pp / (DEPTH * PH_PER), l = (pp / PH_PER) % DEPTH, site = (ph < 2) ? 100 + ph : pp % PH_PER + 1;
#define P_XN ((bf16_t*)(args.ws + WS_XN))
#define P_UA ((bf16_t*)(args.ws + WS_UA))
#define P_GV ((bf16_t*)(args.ws + WS_GV))
#define P_UB ((bf16_t*)(args.ws + WS_UB))
#define P_GATE ((bf16_t*)(args.ws + WS_GATE))
#define P_Z ((bf16_t*)(args.ws + WS_Z))
#define P_SB ((float*)(args.ws + WS_SB))
#define P_SQ ((float*)(args.ws + WS_SQ))
#define P_HB ((bf16_t*)(args.ws + WS_H))
#define P_XOUT (args.out + (size_t)slab * TS * D)
#define P_WT (args.ws + WS_WT + (size_t)l * WT_LAYER)
#define P_S5 (args.ws + WS_S5 + (size_t)l * S5_LAYER)
        if (site == 3 || site == 7 || (gridDim.x == 256 && (site == 9 || site == 12))) continue;
        switch (site) {
        case 100: SITE(100) { MKFRAME; prologue_a(F, args); } break;
        case 101: SITE(101) { MKFRAME; prologue_b(F, args); } break;
        case 1: SITE(1) { MKFRAME;
            pg8::Gemm g{P_XN, (const bf16_t*)(P_WT + WT_IN), D, D, D, 0, 0}; pg8::StaticOrder S; S.init(TS, INW, F.G, F.bx);
            pg8::EpiIn E{P_UA, P_GV, P_UB, P_GATE, P_SQ}; pg8::gemm_phase(F.lds, g, S, E); } break;
        case 2: SITE(2) { MKFRAME;
            { pg8::Gemm g{P_UB, (const bf16_t*)(P_S5 + S5_WST), KS5, 512, 512, (size_t)NCH * KS5 * 2, (size_t)256 * 512 * 2}; pg8::BatchOrder S; S.init(NCH, 256, NG, F.G, F.vcu);
              pg8::EpiState E{P_SB}; pg8::gemm_phase(F.lds, g, S, E); }
            gating_phase(F, args, l, P_UA, P_GV, P_SQ); } break;
        case 4: SITE(4) { MKFRAME;
            scan_phase(F, args, l, P_SB, P_UB);
            pg8::Gemm g{P_UA, (const bf16_t*)(P_WT + WT_OA), D, D, D, 0, 0}; pg8::StaticOrder S; S.init(TS, D, F.G, F.bx);
            pg8::EpiMixA E{P_GATE, P_GV}; pg8::gemm_phase(F.lds, g, S, E); } break;
        case 5: SITE(5) { MKFRAME;
            pg8::Gemm g{P_UB, (const bf16_t*)(P_S5 + S5_TV), KS5, KS5, KS5, (size_t)NCH * KS5 * 2, (size_t)512 * KS5 * 2}; pg8::BatchOrder S; S.init(NCH, 512, NG, F.G, F.vcu);
            pg8::EpiS5 E{P_Z}; pg8::gemm_phase(F.lds, g, S, E); } break;
        case 6: SITE(6) { MKFRAME;
            pg8::Gemm g{P_Z, (const bf16_t*)(P_WT + WT_GLU), D, D, D, 0, 0}; pg8::StaticOrder S; S.init(TS, 2048, F.G, F.bx);
            pg8::EpiGlu E{P_GATE, P_GV, P_UA}; pg8::gemm_phase(F.lds, g, S, E); } break;
        case 8: SITE(8) { MKFRAME;
            pg8::Gemm g{P_UA, (const bf16_t*)(P_WT + WT_O), D, D, D, 0, 0}; pg8::StaticOrder S; S.init(TS, D, F.G, F.bx);
            if (F.G == 256) { const int itb = (slab * DEPTH + l) * 4;
                pg8::EpiRmsRes E{(l == 0) ? x_in_row(args, slab, 0) : nullptr, (l == 0) ? nullptr : (const bf16_t*)(args.ws + WS_XH), nullptr, (bf16_t*)(args.ws + WS_XH), args.in[I_NPOM] + l * D, args.in[I_NPF] + l * D, P_XN, (float*)(args.ws + WS_XB) + (size_t)itb * 64 * 256 * 4, (unsigned*)(args.ws + WS_CNT) + (size_t)itb * 64 * 64};
                pg8::gemm_phase(F.lds, g, S, E); }
            else { pg8::EpiSq E{P_XN, P_SQ}; pg8::gemm_phase(F.lds, g, S, E); } } break;
        case 9: SITE(9) { MKFRAME;
            if (F.G != 256) { const float* xin = (l == 0) ? x_in_row(args, slab, 0) : P_XOUT;
                resnorm(F, xin, P_XN, P_SQ, args.in[I_NPOM] + l * D, P_XOUT, args.in[I_NPF] + l * D, P_XN); } } break;
        case 10: SITE(10) { MKFRAME;
            pg8::Gemm g{P_XN, (const bf16_t*)(P_WT + WT_FF1), D, D, D, 0, 0}; pg8::StaticOrder S; S.init(TS, FF, F.G, F.bx);
            pg8::EpiRelu2 E{P_HB}; pg8::gemm_phase(F.lds, g, S, E, (u32x4*)(args.ws + 510 * MiB) + (size_t)F.bx * 512); } break;
        case 11: SITE(11) { MKFRAME;
            pg8::Gemm g{P_HB, (const bf16_t*)(P_WT + WT_FF2), FF, FF, FF, 0, 0}; pg8::StaticOrder S; S.init(TS, D, F.G, F.bx);
            if (F.G == 256) { const int itb = (slab * DEPTH + l) * 4 + 2;
                pg8::EpiRmsRes E{nullptr, (const bf16_t*)(args.ws + WS_XH), (l + 1 < DEPTH) ? nullptr : P_XOUT, (l + 1 < DEPTH) ? (bf16_t*)(args.ws + WS_XH) : nullptr, args.in[I_NPOF] + l * D, (l + 1 < DEPTH) ? args.in[I_NPM] + (l + 1) * D : nullptr, P_XN, (float*)(args.ws + WS_XB) + (size_t)itb * 64 * 256 * 4, (unsigned*)(args.ws + WS_CNT) + (size_t)itb * 64 * 64};
                pg8::gemm_phase(F.lds, g, S, E);
                if (l + 1 == DEPTH && slab + 1 < NSLAB) enorm0(F, args, slab + 1, P_XN); }
            else { pg8::EpiSq E{P_Z, P_SQ}; pg8::gemm_phase(F.lds, g, S, E); } } break;
        default: SITE(12) { MKFRAME;
            if (F.G != 256) resnorm(F, P_XOUT, P_Z, P_SQ, args.in[I_NPOF] + l * D, P_XOUT, (l + 1 < DEPTH) ? args.in[I_NPM] + (l + 1) * D : nullptr, P_XN);
            if (l + 1 == DEPTH && slab + 1 < NSLAB) enorm0(F, args, slab + 1, P_XN); } break;
        }
        if (ph + 1 < hi) {
            if (gridDim.x == 256 && (site == 6 || site == 10)) {
                const int c = blockIdx.x, pmg = (c % 8) * 8 + (c / 8) % 8, bank = (slab * DEPTH + l) * 2 + (site == 10 ? 1 : 0);
                panel_group_barrier((unsigned*)(args.ws + WS_GCNT) + (size_t)bank * 64 * 64 + pmg * 64);
            } else xcd_barrier(xbar);
        }
    }
#undef SITE
}


extern "C" void kernel_launch(void* const* d_in, const int* in_sizes, int n_in, void* d_out, int out_size, void* d_ws, size_t ws_size, hipStream_t stream) {
    static int grid = 0;
    if (grid == 0) {
        if (n_in != 23 || out_size != NSLAB * TS * D || ws_size < WS_END) { fprintf(stderr, "kernel_launch: unexpected shapes (n_in %d out %d ws %zu)\n", n_in, out_size, ws_size); grid = -1; return; }
        int dev = 0, cus = 0, per_cu = 0;
        hipGetDevice(&dev); hipDeviceGetAttribute(&cus, hipDeviceAttributeMultiprocessorCount, dev);
        if (hipFuncSetAttribute((const void*)mega_fwd, hipFuncAttributeMaxDynamicSharedMemorySize, LDS_BYTES) != hipSuccess) { fprintf(stderr, "kernel_launch: hipFuncSetAttribute failed\n"); grid = -1; return; }
        if (hipOccupancyMaxActiveBlocksPerMultiprocessor(&per_cu, (const void*)mega_fwd, 512, LDS_BYTES) != hipSuccess || per_cu < 1) { fprintf(stderr, "kernel_launch: occupancy query says %d\n", per_cu); per_cu = 1; }
        (void)hipGetLastError();
        grid = cus;
        if (grid % 8 != 0 || grid <= 0) grid = 256;
    }
    if (grid < 0) return;
    Args a{};
    for (int i = 0; i < 23; ++i) a.in[i] = (const float*)d_in[i];
    a.out = (float*)d_out; a.ws = (unsigned char*)d_ws;
#if MK_MULTI
    for (int p = 0; p < NPH; ++p) { a.ph_lo = p; a.ph_hi = p + 1; hipLaunchKernelGGL(mega_fwd, dim3(grid), dim3(512), LDS_BYTES, stream, a);
    }
#else
    a.ph_lo = 0; a.ph_hi = NPH;
    (void)hipMemsetAsync(d_ws, 0, CTL_ZERO, stream);
    void* kargs[] = {&a};
    hipError_t e = hipLaunchCooperativeKernel((const void*)mega_fwd, dim3(grid), dim3(512), kargs, LDS_BYTES, stream);
    if (e != hipSuccess) fprintf(stderr, "kernel_launch: cooperative launch failed: %s (grid %d)\n", hipGetErrorString(e), grid);
#endif
}
```
